# Optimizing an MI355X kernel written in HIP

```python
import math
import jax, jax.numpy as jnp
from jax import lax
import numpy as np

D_MODEL = 4096
BATCH = 2
SEQ = 8192
DEPTH = 1

CTX_LEN = 256
GRID_W = 64
MIX_W = D_MODEL
FOURIER_HEADS = 4
FOURIER_W = MIX_W // 2
FOURIER_HEAD_DIM = FOURIER_W // FOURIER_HEADS
S5_W = MIX_W - FOURIER_W
S5_GROUP = 16
S5_GROUPS = S5_W // S5_GROUP
S5_STATE = 64
FFN_HIDDEN = -(-8 * D_MODEL // (3 * 256)) * 256
N_MOD = 6
EPS = 1e-6
DT_MIN = 1e-3
DT_MAX = 1e-1

kernel_name = "fnet_s5_hybrid_prefix_dit_block"


def rms_norm(x, g):
    xf = x.astype(jnp.float32)
    y = xf * lax.rsqrt(jnp.mean(xf * xf, axis=-1, keepdims=True) + EPS)
    return (y * g.astype(jnp.float32)).astype(x.dtype)


def modulate(h, shift, scale):
    return h * (1 + scale) + shift


def fourier_mixer(u, w_f):
    bsz, length, _ = u.shape
    uh = u.reshape(bsz, length, FOURIER_HEADS, FOURIER_HEAD_DIM).astype(jnp.float32)
    f = jnp.fft.fftn(uh, axes=(1, 3), norm="ortho").real.astype(u.dtype)
    y = jnp.einsum('blhd,hde->blhe', f, w_f)
    return y.reshape(bsz, length, FOURIER_W)


def _ssm_combine(e1, e2):
    a1, b1 = e1
    a2, b2 = e2
    return a1 * a2, a2 * b1 + b2


def s5_scan(u, h0, lam_re, lam_im, log_dt, b_re, b_im, c_re, c_im):
    f32 = jnp.float32
    dt = jnp.exp(log_dt.astype(f32))[:, None]
    lam = lax.complex(jnp.minimum(lam_re.astype(f32), -1e-4), lam_im.astype(f32))
    lam_dt = lam * dt
    lam_bar = jnp.exp(lam_dt)
    b_bar = ((lam_bar - 1) / lam)[..., None] * lax.complex(b_re.astype(f32), b_im.astype(f32))
    c_mat = lax.complex(c_re.astype(f32), c_im.astype(f32))
    steps = jnp.arange(1, GRID_W + 1, dtype=f32)[:, None, None]
    carry_decay = jnp.exp(lam_dt[None] * steps)
    bsz, length, n_groups, group_w = u.shape
    rows = length // GRID_W
    u_rows = jnp.moveaxis(u.reshape(bsz, rows, GRID_W, n_groups, group_w), 1, 0)

    def row_step(h, u_r):
        bu = jnp.einsum('gph,bwgh->bwgp', b_bar, u_r.astype(jnp.complex64))
        a = jnp.broadcast_to(lam_bar, bu.shape)
        _, hs = lax.associative_scan(_ssm_combine, (a, bu), axis=1)
        hs = hs + carry_decay[None] * h[:, None]
        y = jnp.einsum('ghp,bwgp->bwgh', c_mat, hs).real
        return hs[:, -1], y

    h_last, ys = lax.scan(row_step, h0, u_rows)
    return jnp.moveaxis(ys, 0, 1).reshape(bsz, length, n_groups, group_w), h_last


def s5_bidir(u, h0_f, h0_b, lam_re, lam_im, log_dt, b_re, b_im, c_re, c_im, d_skip):
    bsz, length, _ = u.shape
    uf = u.astype(jnp.float32)
    ug = uf.reshape(bsz, length, S5_GROUPS, S5_GROUP)
    y_f, h_f = s5_scan(ug, h0_f, lam_re[0], lam_im[0], log_dt[0], b_re[0], b_im[0], c_re[0], c_im[0])
    y_b, h_b = s5_scan(jnp.flip(ug, 1), h0_b, lam_re[1], lam_im[1], log_dt[1], b_re[1], b_im[1], c_re[1], c_im[1])
    y = (y_f + jnp.flip(y_b, 1)).reshape(bsz, length, S5_W) + d_skip.astype(jnp.float32) * uf
    return y.astype(u.dtype), h_f, h_b


def s5_glu(y, w_a, b_a, w_b, b_b):
    g = jax.nn.gelu(y)
    return (g @ w_a + b_a) * jax.nn.sigmoid(g @ w_b + b_b)


def swiglu(h, w_gate, w_up, w_down):
    return (jax.nn.silu(h @ w_gate) * (h @ w_up)) @ w_down


def setup_inputs(seed: int = 0) -> dict:
    key = jax.random.key(seed)
    ks = jax.random.split(key, 32)
    f32 = jnp.float32
    nrm = lambda k, s, std: jax.random.normal(k, s, f32) * std
    G, P, H = S5_GROUPS, S5_STATE, S5_GROUP
    ada_std = 0.5 * D_MODEL ** -0.5
    lam_im = math.pi * jnp.arange(P, dtype=f32)[None, None, None, :] + nrm(ks[10], (DEPTH, 2, G, P), 0.01)
    return {
        "x": nrm(ks[0], (BATCH, SEQ, D_MODEL), 1.0),
        "c": nrm(ks[1], (BATCH, D_MODEL), 1.0),
        "ctx": nrm(ks[2], (BATCH, CTX_LEN, D_MODEL), 1.0),
        "c_ctx": nrm(ks[3], (D_MODEL,), 1.0),
        "ada_w": nrm(ks[4], (DEPTH, D_MODEL, N_MOD * D_MODEL), ada_std),
        "ada_b": nrm(ks[5], (DEPTH, N_MOD * D_MODEL), 0.01),
        "norm1_g": 1.0 + nrm(ks[6], (DEPTH, D_MODEL), 0.01),
        "norm2_g": 1.0 + nrm(ks[7], (DEPTH, D_MODEL), 0.01),
        "w_in": nrm(ks[8], (DEPTH, D_MODEL, MIX_W), D_MODEL ** -0.5),
        "w_out": nrm(ks[9], (DEPTH, MIX_W, D_MODEL), MIX_W ** -0.5),
        "fourier_w": nrm(ks[11], (DEPTH, FOURIER_HEADS, FOURIER_HEAD_DIM, FOURIER_HEAD_DIM), FOURIER_HEAD_DIM ** -0.5),
        "s5_lam_re": -0.5 + nrm(ks[12], (DEPTH, 2, G, P), 0.01),
        "s5_lam_im": lam_im,
        "s5_log_dt": jax.random.uniform(ks[13], (DEPTH, 2, G), f32, math.log(DT_MIN), math.log(DT_MAX)),
        "s5_b_re": nrm(ks[14], (DEPTH, 2, G, P, H), (2.0 * H) ** -0.5),
        "s5_b_im": nrm(ks[15], (DEPTH, 2, G, P, H), (2.0 * H) ** -0.5),
        "s5_c_re": nrm(ks[16], (DEPTH, 2, G, H, P), (2.0 * P) ** -0.5),
        "s5_c_im": nrm(ks[17], (DEPTH, 2, G, H, P), (2.0 * P) ** -0.5),
        "s5_d": nrm(ks[18], (DEPTH, S5_W), 1.0),
        "glu_w_a": nrm(ks[19], (DEPTH, S5_W, S5_W), S5_W ** -0.5),
        "glu_b_a": nrm(ks[20], (DEPTH, S5_W), 0.01),
        "glu_w_b": nrm(ks[21], (DEPTH, S5_W, S5_W), S5_W ** -0.5),
        "glu_b_b": nrm(ks[22], (DEPTH, S5_W), 0.01),
        "ffn_w_gate": nrm(ks[23], (DEPTH, D_MODEL, FFN_HIDDEN), D_MODEL ** -0.5),
        "ffn_w_up": nrm(ks[24], (DEPTH, D_MODEL, FFN_HIDDEN), D_MODEL ** -0.5),
        "ffn_w_down": nrm(ks[25], (DEPTH, FFN_HIDDEN, D_MODEL), FFN_HIDDEN ** -0.5),
        "final_g": 1.0 + nrm(ks[26], (D_MODEL,), 0.01),
    }


def reference(x, c, ctx, c_ctx, ada_w, ada_b, norm1_g, norm2_g, w_in, w_out, fourier_w,
              s5_lam_re, s5_lam_im, s5_log_dt, s5_b_re, s5_b_im, s5_c_re, s5_c_im, s5_d,
              glu_w_a, glu_b_a, glu_w_b, glu_b_b, ffn_w_gate, ffn_w_up, ffn_w_down, final_g):
    bsz = x.shape[0]
    h_zero = jnp.zeros((bsz, S5_GROUPS, S5_STATE), jnp.complex64)
    for layer in range(DEPTH):
        last = layer == DEPTH - 1
        s5_p = (s5_lam_re[layer], s5_lam_im[layer], s5_log_dt[layer], s5_b_re[layer], s5_b_im[layer],
                s5_c_re[layer], s5_c_im[layer], s5_d[layer])
        glu_p = (glu_w_a[layer], glu_b_a[layer], glu_w_b[layer], glu_b_b[layer])
        ffn_p = (ffn_w_gate[layer], ffn_w_up[layer], ffn_w_down[layer])
        mod = (jax.nn.silu(c) @ ada_w[layer] + ada_b[layer]).reshape(bsz, 1, N_MOD, D_MODEL)
        mod_c = (jax.nn.silu(c_ctx) @ ada_w[layer] + ada_b[layer]).reshape(1, 1, N_MOD, D_MODEL)
        sh1, sc1, g1, sh2, sc2, g2 = (mod[:, :, i] for i in range(N_MOD))
        csh1, csc1, cg1, csh2, csc2, cg2 = (mod_c[:, :, i] for i in range(N_MOD))

        hc = modulate(rms_norm(ctx, norm1_g[layer]), csh1, csc1)
        yc_s, hf_ctx, hb_ctx = s5_bidir(hc @ w_in[layer][:, FOURIER_W:], h_zero, h_zero, *s5_p)

        h = modulate(rms_norm(x, norm1_g[layer]), sh1, sc1)
        z = h @ w_in[layer]
        y_four = fourier_mixer(z[..., :FOURIER_W], fourier_w[layer])
        y_s, _, _ = s5_bidir(z[..., FOURIER_W:], hf_ctx, hb_ctx, *s5_p)
        y_s = s5_glu(y_s, *glu_p)
        x = x + g1 * (jnp.concatenate([y_four, y_s], axis=-1) @ w_out[layer])
        x = x + g2 * swiglu(modulate(rms_norm(x, norm2_g[layer]), sh2, sc2), *ffn_p)

        if not last:
            yc_four = fourier_mixer(hc @ w_in[layer][:, :FOURIER_W], fourier_w[layer])
            yc = jnp.concatenate([yc_four, s5_glu(yc_s, *glu_p)], axis=-1) @ w_out[layer]
            ctx = ctx + cg1 * yc
            ctx = ctx + cg2 * swiglu(modulate(rms_norm(ctx, norm2_g[layer]), csh2, csc2), *ffn_p)
    return rms_norm(x, final_g)
```

```cpp
#include <hip/hip_runtime.h>
#include <cstdio>
#include <cstdint>
#include <cmath>

#define LAS __attribute__((address_space(3)))
#define GAS __attribute__((address_space(1)))
#define HD __host__ __device__ __forceinline__
typedef unsigned short bf16;
typedef short bf16x8 __attribute__((ext_vector_type(8)));
typedef float f32x4 __attribute__((ext_vector_type(4)));
typedef float f32x2 __attribute__((ext_vector_type(2)));
typedef unsigned u32x4 __attribute__((ext_vector_type(4)));
typedef unsigned u32x2 __attribute__((ext_vector_type(2)));

constexpr int DM = 4096, NB = 2, SEQ = 8192, CTXL = 256, FFN = 11008;
constexpr int MTOK = NB * SEQ;
constexpr int MCTX = NB * CTXL;
constexpr int FW = 2048, FH = 4, FHD = 512;
constexpr int SG = 128, SH = 16, SP = 64;
constexpr int CH = 16, NCH = SEQ / CH;
constexpr int LS = 128, LF = 64;
constexpr float EPS = 1e-6f;

#ifndef MK_PER_PHASE
#define MK_PER_PHASE 0
#endif

HD unsigned f2bf(float f) { unsigned u = __builtin_bit_cast(unsigned, f); return (u + 0x7fffu + ((u >> 16) & 1u)) >> 16; }
HD unsigned pk2(float lo, float hi) { return f2bf(lo) | (f2bf(hi) << 16); }
HD float bf2f(bf16 b) { return __builtin_bit_cast(float, (unsigned)b << 16); }

namespace gg {
constexpr int BM = 256, BK = 64, HALF = 128, HTB = HALF * BK * 2, STAGE_BYTES = 8 * HTB, NXCD = 8, WGM = 8;
HD int lds_byte(int r, int c) { const int st = (r >> 4) * 2 + (c >> 5), rr = r & 15, cc = c & 31, ob = rr * 64 + cc * 2; return st * 1024 + (ob ^ (((ob >> 9) & 1) << 5)); }
HD void stage_rc(int b, int& R, int& C) { const int st = b / 1024, sb = b % 1024, swz = sb ^ (((sb >> 9) & 1) << 5); R = (st >> 1) * 16 + swz / 64; C = (st & 1) * 32 + (swz % 64) / 2; }
HD int perm32(int rho) { const int n = rho >> 4, i = rho & 15; return 8 * (i >> 2) + 4 * n + (i & 3); }

struct Unit { size_t aoff, boff; int pm, pn, z; };
struct Gemm { const char* A; const char* B; unsigned lda, ldb; int nt;
              unsigned csa = 32, csb = 32;
              size_t ksa = 128, ksb = 128; };
HD size_t elem_off(unsigned ld, unsigned cs, size_t ks, int r, int k) { return (size_t)r * ld + (size_t)(k >> 6) * ks + (size_t)((k & 63) >> 4) * cs + (size_t)(k & 15) * 2; }

struct Order2D {
    int nM, nN, nwg, G, c; size_t ta, tb;
    HD void init(int nM_, int nN_, int G_, int c_, unsigned lda, unsigned ldb) { nM = nM_; nN = nN_; nwg = nM * nN; G = G_; c = c_; ta = (size_t)BM * lda; tb = (size_t)BM * ldb; }
    HD bool next(int i, Unit& u) const {
        const long L = (long)i * G + c; if (L >= nwg) return false;
        int wgid = (int)L; { const int q = nwg / NXCD, r = nwg % NXCD, xcd = wgid % NXCD, off = wgid / NXCD; wgid = (xcd < r ? xcd * (q + 1) : r * (q + 1) + (xcd - r) * q) + off; }
        const int nig = WGM * nN, gid = wgid / nig, fm = gid * WGM, gsz = (nM - fm) < WGM ? (nM - fm) : WGM;
        u.pm = fm + ((wgid % nig) % gsz); u.pn = (wgid % nig) / gsz; u.z = 0; u.aoff = (size_t)u.pm * ta; u.boff = (size_t)u.pn * tb; return true;
    }
};
struct OrderS5 {
    int G, c; size_t bstride;
    HD bool next(int i, Unit& u) const {
        const int L = i * G + c; if (L >= SG * 4) return false;
        const int xcd = L & 7, q = L >> 3; u.pm = q & 3; u.z = (q >> 2) * 8 + xcd; u.pn = 0;
        u.aoff = ((size_t)u.z * 1024 + (size_t)u.pm * 256) * 1024; u.boff = (size_t)u.z * bstride; return true;
    }
};
struct OrderF1 {
    int G, c;
    HD bool next(int i, Unit& u) const {
        const int L = i * G + c; if (L >= FH * 4 * 64) return false;
        u.pn = L & 63; u.pm = (L >> 6) & 3; u.z = L >> 8;
        u.aoff = ((size_t)u.z * 1024 + (size_t)u.pm * 256) * (FHD * 2); u.boff = (size_t)u.pn * 256 * (FW * 2) + (size_t)u.z * (FHD * 2); return true;
    }
};
struct OrderLin {
    int n, G, c; size_t bstep;
    HD bool next(int i, Unit& u) const { const int L = i * G + c; if (L >= n) return false; u.pm = 0; u.pn = L; u.z = 0; u.aoff = 0; u.boff = (size_t)L * bstep; return true; }
};

HD unsigned cvt_pk_bf16(float lo, float hi) {
#if defined(__HIP_DEVICE_COMPILE__)
    unsigned r; asm volatile("v_cvt_pk_bf16_f32 %0, %1, %2" : "=v"(r) : "v"(lo), "v"(hi)); return r;
#else
    return pk2(lo, hi);
#endif
}
HD u32x4 pack8(const f32x4& v0, const f32x4& v1) { u32x4 w; w.x = cvt_pk_bf16(v0[0], v0[1]); w.y = cvt_pk_bf16(v0[2], v0[3]); w.z = cvt_pk_bf16(v1[0], v1[1]); w.w = cvt_pk_bf16(v1[2], v1[3]); return w; }

template <class Epi, class Sched, bool ALIGN_EPI, bool BD = false>
__device__ __forceinline__ void gemm_phase(LAS unsigned char* lds, const Gemm g, const Sched& S, const Epi& E) {
    const int tid = threadIdx.x, wid = __builtin_amdgcn_readfirstlane(tid >> 6), lane = tid & 63, wr = wid >> 2, wc = wid & 3, fr = lane & 15, fq = lane >> 4;
    int nt = g.nt; asm volatile("" : "+s"(nt));
    unsigned voffA[2], voffB[2];
#pragma unroll
    for (int i = 0; i < 2; ++i) { int R, C; stage_rc(tid * 16 + i * 8192, R, C); const int Rb = (R & ~31) + perm32(R & 31);
        voffA[i] = (unsigned)R * g.lda + (unsigned)(C >> 4) * g.csa + (unsigned)(C & 15) * 2u; voffB[i] = (unsigned)Rb * g.ldb + (unsigned)(C >> 4) * g.csb + (unsigned)(C & 15) * 2u; }
    const size_t kstepA = g.ksa, kstepB = g.ksb;
    const size_t hstepA = (size_t)HALF * g.lda, hstepB = (size_t)HALF * g.ldb;
    const unsigned ldsw = (unsigned)wid * 1024u;
    const int aoff = lds_byte(wr * 64 + fr, fq * 8), boff = lds_byte(wc * 32 + fr, fq * 8);
#define PG8_SA(b, h) (((b) * 2 + (h)) * HTB)
#define PG8_SB(b, h) ((4 + (b) * 2 + (h)) * HTB)
#define PG8_STAGE(bufoff, gbase, voff) do { _Pragma("unroll") for (int _i = 0; _i < 2; ++_i) \
        __builtin_amdgcn_global_load_lds((const unsigned*)((const char*)(gbase) + (voff)[_i]), (LAS unsigned*)(lds + (bufoff) + ldsw + _i * 8192), 16, 0, 0); } while (0)
#define PG8_LDA(dst, b, h) do { _Pragma("unroll") for (int m = 0; m < 4; ++m) _Pragma("unroll") for (int k = 0; k < 2; ++k) dst[m][k] = *(const LAS bf16x8*)(lds + PG8_SA(b, h) + aoff + m * 2048 + k * 1024); } while (0)
#define PG8_LDB(dst, b, h) do { _Pragma("unroll") for (int n = 0; n < 2; ++n) _Pragma("unroll") for (int k = 0; k < 2; ++k) dst[n][k] = *(const LAS bf16x8*)(lds + PG8_SB(b, h) + boff + n * 2048 + k * 1024); } while (0)
#define PG8_MMA(ai, bj, At, Bt) do { __builtin_amdgcn_s_setprio(1); _Pragma("unroll") for (int m = 0; m < 4; ++m) _Pragma("unroll") for (int n = 0; n < 2; ++n) _Pragma("unroll") for (int k = 0; k < 2; ++k) \
        acc[ai][bj][m][n] = __builtin_amdgcn_mfma_f32_16x16x32_bf16(Bt[n][k], At[m][k], acc[ai][bj][m][n], 0, 0, 0); __builtin_amdgcn_s_setprio(0); } while (0)
#define PG8_WAIT_V(n) asm volatile("s_waitcnt vmcnt(" #n ")" ::: "memory")
#define PG8_WAIT_L(n) asm volatile("s_waitcnt lgkmcnt(" #n ")" ::: "memory")
#define PG8_BAR __builtin_amdgcn_s_barrier()
#define PG8_SCHED __builtin_amdgcn_sched_barrier(0)
    Unit cur, nxt; int ui = 0;
    if (!S.next(0, cur)) return;
    f32x4 acc[2][2][4][2];
#pragma unroll
    for (int a = 0; a < 2; ++a)
#pragma unroll
        for (int b = 0; b < 2; ++b)
#pragma unroll
            for (int m = 0; m < 4; ++m)
#pragma unroll
                for (int n = 0; n < 2; ++n) acc[a][b][m][n] = (f32x4){0.f, 0.f, 0.f, 0.f};
    bf16x8 At[4][2], B0[2][2], B1[2][2];
    const char* cA = g.A + cur.aoff; const char* cB = g.B + cur.boff;
    PG8_STAGE(PG8_SB(0, 0), cB, voffB); PG8_STAGE(PG8_SB(0, 1), cB + hstepB, voffB); PG8_STAGE(PG8_SA(0, 0), cA, voffA); PG8_STAGE(PG8_SA(0, 1), cA + hstepA, voffA);
    if (wr == 1) PG8_BAR;
    PG8_WAIT_V(2); PG8_BAR;
    PG8_STAGE(PG8_SB(1, 0), cB + kstepB, voffB); PG8_STAGE(PG8_SA(1, 0), cA + kstepA, voffA); PG8_STAGE(PG8_SB(1, 1), cB + hstepB + kstepB, voffB);
    PG8_WAIT_V(6); PG8_BAR;
    for (;;) {
        const bool has_next = S.next(ui + 1, nxt);
        const char* nA = has_next ? g.A + nxt.aoff : cA; const char* nB = has_next ? g.B + nxt.boff : cB;
        for (int t = 0; t < nt; t += 2) {
            const bool last = (t == nt - 2);
            const char* a1 = cA + (size_t)(t + 1) * kstepA;
            const char* a2 = last ? nA : cA + (size_t)(t + 2) * kstepA; const char* b2 = last ? nB : cB + (size_t)(t + 2) * kstepB;
            const char* a3 = a2 + kstepA; const char* b3 = b2 + kstepB;
            const bool do0 = !BD || ((t >> 1) == wr), do1 = !BD || ((t >> 1) == 2 + wr);
            PG8_LDB(B0, 0, 0); PG8_LDB(B1, 0, 1); PG8_SCHED; PG8_LDA(At, 0, 0); PG8_STAGE(PG8_SA(1, 1), a1 + hstepA, voffA);
            PG8_WAIT_V(8); PG8_WAIT_L(0); PG8_BAR; if (do0) { PG8_MMA(0, 0, At, B0); PG8_MMA(0, 1, At, B1); } PG8_BAR; PG8_SCHED;
            PG8_LDA(At, 0, 1); PG8_STAGE(PG8_SB(0, 0), b2, voffB); PG8_STAGE(PG8_SB(0, 1), b2 + hstepB, voffB); PG8_STAGE(PG8_SA(0, 0), a2, voffA);
            PG8_WAIT_V(8); PG8_WAIT_L(0); PG8_BAR; if (do1) { PG8_MMA(1, 0, At, B0); PG8_MMA(1, 1, At, B1); } PG8_BAR; PG8_SCHED;
            PG8_LDB(B0, 1, 0); PG8_LDB(B1, 1, 1); PG8_SCHED; PG8_LDA(At, 1, 0); PG8_STAGE(PG8_SA(0, 1), a2 + hstepA, voffA);
            PG8_WAIT_V(8); PG8_WAIT_L(0); PG8_BAR; if (do0) { PG8_MMA(0, 0, At, B0); PG8_MMA(0, 1, At, B1); } PG8_BAR; PG8_SCHED;
            PG8_LDA(At, 1, 1); PG8_STAGE(PG8_SB(1, 0), b3, voffB); PG8_STAGE(PG8_SB(1, 1), b3 + hstepB, voffB); PG8_STAGE(PG8_SA(1, 0), a3, voffA);
            PG8_WAIT_V(8); PG8_WAIT_L(0); PG8_BAR; if (do1) { PG8_MMA(1, 0, At, B0); PG8_MMA(1, 1, At, B1); } PG8_BAR; PG8_SCHED;
        }
        if constexpr (ALIGN_EPI) { if (wr == 0) PG8_BAR; }
        { int fr2 = fr, fq2 = fq; asm volatile("" : "+v"(fr2), "+v"(fq2));
          E(acc, cur, wr, wc, fr2, fq2); }
        if (!has_next) break;
#pragma unroll
        for (int a = 0; a < 2; ++a)
#pragma unroll
            for (int b = 0; b < 2; ++b)
#pragma unroll
                for (int m = 0; m < 4; ++m)
#pragma unroll
                    for (int n = 0; n < 2; ++n) acc[a][b][m][n] = (f32x4){0.f, 0.f, 0.f, 0.f};
        cur = nxt; cA = nA; cB = nB; ++ui;
        if constexpr (ALIGN_EPI) { if (wr == 1) PG8_BAR; }
    }
    PG8_WAIT_V(0);
    if constexpr (!ALIGN_EPI) { if (wr == 0) PG8_BAR; }
    PG8_BAR;
#undef PG8_SA
#undef PG8_SB
#undef PG8_STAGE
#undef PG8_LDA
#undef PG8_LDB
#undef PG8_MMA
#undef PG8_WAIT_V
#undef PG8_WAIT_L
#undef PG8_BAR
#undef PG8_SCHED
}
}

constexpr size_t MiB = 1u << 20;
constexpr size_t WS_CTL = 0, CTL_ZERO_BYTES = 1 * MiB;
constexpr size_t WS_MOD  = 1 * MiB;
constexpr size_t WS_F1   = 2 * MiB;
constexpr size_t WS_F2   = 2 * MiB + 256 * 1024;
constexpr size_t WS_TW   = 3 * MiB;
constexpr size_t WS_ZC   = 4 * MiB;
constexpr size_t WS_WIN  = 8 * MiB;
constexpr size_t WS_WOUT = 40 * MiB;
constexpr size_t WS_WGLU = 72 * MiB;
constexpr size_t WS_WGU  = 88 * MiB;
constexpr size_t WS_WDN  = 260 * MiB;
constexpr size_t WS_WCS  = 346 * MiB;
constexpr size_t WS_SB   = 350 * MiB;
constexpr size_t WS_KC   = 366 * MiB;
constexpr size_t WS_HN   = 398 * MiB;
constexpr size_t WS_CAT  = 530 * MiB;
constexpr size_t WS_G    = 658 * MiB;
constexpr size_t WS_ZF   = 722 * MiB;
constexpr size_t WS_UH   = 786 * MiB;
constexpr size_t WS_SST  = 914 * MiB;
constexpr size_t WS_X1   = 978 * MiB;
constexpr size_t WS_X2   = 1106 * MiB;
constexpr size_t WS_HID  = 722 * MiB;
constexpr size_t WS_XR   = 1234 * MiB;
constexpr size_t WS_END  = 1362 * MiB;
static_assert(WS_HID + (size_t)MTOK * FFN * 2 <= WS_END, "ws map");
constexpr int CW_TMO = 0, CW_CODE = 1, CW_BAR = 4096;

constexpr int RING_OFF = 0, RING_BYTES = 131072;
constexpr int LDSCTL_OFF = RING_BYTES, MISC_OFF = LDSCTL_OFF + 320;
constexpr int LDS_BYTES = 147456;
constexpr int NWAVES = 8;

HD void sincos_rev(float rev, float& s, float& c) {
#if defined(__HIP_DEVICE_COMPILE__)
    s = __builtin_amdgcn_sinf(rev); c = __builtin_amdgcn_cosf(rev);
#else
    const double a = 6.283185307179586476925 * (double)rev; s = (float)sin(a); c = (float)cos(a);
#endif
}
HD void st16(bf16* p, const u32x4& w) { *(u32x4*)p = w; }
#if defined(__HIP_DEVICE_COMPILE__)
#define FEXP(x) __expf(x)
#else
#define FEXP(x) expf(x)
#endif
#if defined(__HIP_DEVICE_COMPILE__)
#define FRCP(x) __builtin_amdgcn_rcpf(x)
#else
#define FRCP(x) (1.f / (x))
#endif
HD float sigmoid_f(float x) { return FRCP(1.f + FEXP(-x)); }
HD float silu_f(float x) { return x * sigmoid_f(x); }
HD float gelu_tanh_f(float x) { const float t = 1.5957691216f * (x + 0.044715f * x * x * x); return x * sigmoid_f(t); }

struct EpiZ {
    bf16* ZF; bf16* UH;
    HD void chunk(const gg::Unit& u, int r, int c, const f32x4& v0, const f32x4& v1) const {
        const int row = u.pm * 256 + r, b = row >> 13, l = row & (SEQ - 1);
        if (u.pn < 8) { const int n = u.pn * 256 + c; const size_t rho = (size_t)b * SEQ + (size_t)(l & (LF - 1)) * LS + (l >> 6); st16(ZF + rho * FW + n, gg::pack8(v0, v1)); }
        else { const int n = (u.pn - 8) * 256 + c, g = n >> 4, h0 = n & 15;
            st16(UH + ((size_t)g * 1024 + (size_t)b * NCH + (l >> 4)) * 512 + (l & 15) * 16 + h0, gg::pack8(v0, v1)); }
    }
};
struct EpiS {
    bf16* Sst;
    HD void chunk(const gg::Unit& u, int r, int c, const f32x4& v0, const f32x4& v1) const { st16(Sst + ((size_t)u.z * 1024 + u.pm * 256 + r) * 256 + c, gg::pack8(v0, v1)); }
};
struct EpiY {
    bf16* Gb;
    HD void chunk(const gg::Unit& u, int r, int c, const f32x4& v0, const f32x4& v1) const {
        const int bc = u.pm * 256 + r, b = bc >> 9, ch = bc & (NCH - 1), jo = c >> 4, ho = c & 15;
        f32x4 a, d;
        for (int j = 0; j < 4; ++j) { a[j] = gelu_tanh_f(v0[j]); d[j] = gelu_tanh_f(v1[j]); }
        st16(Gb + (((size_t)u.z * MTOK + (size_t)b * SEQ + ch * CH + jo) * 16 + ho), gg::pack8(a, d));
    }
};
struct EpiGLU {
    bf16* CAT; const float* ba; const float* bb;
    HD void chunk2(const gg::Unit& u, int r, int c, const f32x4& a0, const f32x4& a1, const f32x4& b0, const f32x4& b1) const {
        const int col = u.pn * 128 + c;
        chunk2b(u, r, c, a0, a1, b0, b1, *(const f32x4*)(ba + col), *(const f32x4*)(ba + col + 4), *(const f32x4*)(bb + col), *(const f32x4*)(bb + col + 4));
    }
    HD void chunk2b(const gg::Unit& u, int r, int c, const f32x4& a0, const f32x4& a1, const f32x4& b0, const f32x4& b1, const f32x4& ba0, const f32x4& ba1, const f32x4& bb0, const f32x4& bb1) const {
        const int col = u.pn * 128 + c; f32x4 o0, o1;
        for (int j = 0; j < 4; ++j) { const float x0 = b0[j] + bb0[j], x1 = b1[j] + bb1[j];
            o0[j] = (a0[j] + ba0[j]) * sigmoid_f(x0); o1[j] = (a1[j] + ba1[j]) * sigmoid_f(x1); }
        st16(CAT + (size_t)(u.pm * 256 + r) * DM + FW + col, gg::pack8(o0, o1));
    }
};
struct EpiSwiGLU {
    bf16* Hid;
    HD void chunk2(const gg::Unit& u, int r, int c, const f32x4& g0, const f32x4& g1, const f32x4& u0, const f32x4& u1) const {
        f32x4 h0, h1;
        for (int j = 0; j < 4; ++j) { h0[j] = silu_f(g0[j]) * u0[j]; h1[j] = silu_f(g1[j]) * u1[j]; }
        st16(Hid + (size_t)(u.pm * 256 + r) * FFN + u.pn * 128 + c, gg::pack8(h0, h1));
    }
};
struct EpiF1 {
    bf16* X1;
    HD void chunk(const gg::Unit& u, int r, int c, const f32x4& v0, const f32x4& v1) const {
        const int rr = u.pm * 256 + r, ri = rr >> 9, e = rr & 511, n = u.pn * 256 + c, b = n >> 13, lf = (n >> 7) & (LF - 1), ls = n & (LS - 1);
        st16(X1 + ((((size_t)b * FH + u.z) * FHD + e) * LF + lf) * 256 + ri * LS + ls, gg::pack8(v0, v1));
    }
};
struct EpiF2 {
    bf16* X2; const float* TW;
    HD void chunk2(const gg::Unit& u, int k1, int c, const f32x4& r0, const f32x4& r1, const f32x4& i0, const f32x4& i1) const {
        const int n = u.pn * 256 + c, lf = n & (LF - 1), beh = n >> 6, b = beh >> 11, h = (beh >> 9) & 3, e = beh & 511;
        f32x4 or0, or1, oi0, oi1;
        for (int j = 0; j < 4; ++j) {
            float c0, s0, c1, s1; sincos_rev((float)(k1 * (lf + j)) * (1.f / 8192.f), s0, c0); sincos_rev((float)(k1 * (lf + 4 + j)) * (1.f / 8192.f), s1, c1); s0 = -s0; s1 = -s1;
            or0[j] = r0[j] * c0 - i0[j] * s0; oi0[j] = r0[j] * s0 + i0[j] * c0;
            or1[j] = r1[j] * c1 - i1[j] * s1; oi1[j] = r1[j] * s1 + i1[j] * c1;
        }
        bf16* row = X2 + ((((size_t)b * 32 + (k1 >> 2)) * FH + h) * FHD + e) * 512 + (k1 & 3) * 128 + lf;
        st16(row, gg::pack8(or0, or1)); st16(row + LF, gg::pack8(oi0, oi1));
    }
};
struct EpiF3 {
    bf16* CAT;
    HD void chunk(const gg::Unit& u, int r, int c, const f32x4& v0, const f32x4& v1) const {
        const int j = r >> 6, k2 = r & 63, n = u.pn * 256 + c, e = n & 511, h = (n >> 9) & 3, k1h = (n >> 11) & 31, b = n >> 16;
        const int k = 4 * k1h + j + LS * k2;
        st16(CAT + ((size_t)b * SEQ + k) * DM + h * FHD + e, gg::pack8(v0, v1));
    }
};
struct EpiResidX {
    const float* base; bf16* xr; const float* gate; int gstride;
    __device__ __forceinline__ void operator()(const f32x4 (&acc)[2][2][4][2], const gg::Unit& u, int wr, int wc, int fr, int fq) const {
        const int row0 = u.pm * 256 + 64 * wr + fr, col0 = u.pn * 256 + 32 * wc + 8 * fq; const float* gp = gate + (size_t)(row0 >> 13) * gstride + col0;
        f32x4 gv[2][2];
#pragma unroll
        for (int bj = 0; bj < 2; ++bj) { gv[bj][0] = *(const f32x4*)(gp + 128 * bj); gv[bj][1] = *(const f32x4*)(gp + 128 * bj + 4); }
#pragma unroll
        for (int ai = 0; ai < 2; ++ai) {
            f32x4 bv[4][2][2];
#pragma unroll
            for (int m = 0; m < 4; ++m)
#pragma unroll
                for (int bj = 0; bj < 2; ++bj) { const float* bp = base + (size_t)(row0 + 128 * ai + 16 * m) * DM + col0 + 128 * bj; bv[m][bj][0] = *(const f32x4*)bp; bv[m][bj][1] = *(const f32x4*)(bp + 4); }
#pragma unroll
            for (int m = 0; m < 4; ++m)
#pragma unroll
                for (int bj = 0; bj < 2; ++bj) st16(xr + (size_t)(row0 + 128 * ai + 16 * m) * DM + col0 + 128 * bj, gg::pack8(bv[m][bj][0] + gv[bj][0] * acc[ai][bj][m][0], bv[m][bj][1] + gv[bj][1] * acc[ai][bj][m][1]));
            asm volatile("" ::: "memory");
        }
    }
};
HD f32x4 bf4lo(const u32x4& w) { f32x4 v; v[0] = __builtin_bit_cast(float, w.x << 16); v[1] = __builtin_bit_cast(float, w.x & 0xffff0000u); v[2] = __builtin_bit_cast(float, w.y << 16); v[3] = __builtin_bit_cast(float, w.y & 0xffff0000u); return v; }
HD f32x4 bf4hi(const u32x4& w) { f32x4 v; v[0] = __builtin_bit_cast(float, w.z << 16); v[1] = __builtin_bit_cast(float, w.z & 0xffff0000u); v[2] = __builtin_bit_cast(float, w.w << 16); v[3] = __builtin_bit_cast(float, w.w & 0xffff0000u); return v; }
struct EpiResidB {
    bf16* xr; const float* gate; int gstride;
    __device__ __forceinline__ void operator()(const f32x4 (&acc)[2][2][4][2], const gg::Unit& u, int wr, int wc, int fr, int fq) const {
        const int row0 = u.pm * 256 + 64 * wr + fr, col0 = u.pn * 256 + 32 * wc + 8 * fq; const float* gp = gate + (size_t)(row0 >> 13) * gstride + col0;
        f32x4 gv[2][2];
#pragma unroll
        for (int bj = 0; bj < 2; ++bj) { gv[bj][0] = *(const f32x4*)(gp + 128 * bj); gv[bj][1] = *(const f32x4*)(gp + 128 * bj + 4); }
        u32x4 bv[2][4][2];
#pragma unroll
        for (int ai = 0; ai < 2; ++ai)
#pragma unroll
            for (int m = 0; m < 4; ++m)
#pragma unroll
                for (int bj = 0; bj < 2; ++bj) bv[ai][m][bj] = *(const u32x4*)(xr + (size_t)(row0 + 128 * ai + 16 * m) * DM + col0 + 128 * bj);
#pragma unroll
        for (int ai = 0; ai < 2; ++ai)
#pragma unroll
            for (int m = 0; m < 4; ++m)
#pragma unroll
                for (int bj = 0; bj < 2; ++bj) st16(xr + (size_t)(row0 + 128 * ai + 16 * m) * DM + col0 + 128 * bj, gg::pack8(bf4lo(bv[ai][m][bj]) + gv[bj][0] * acc[ai][bj][m][0], bf4hi(bv[ai][m][bj]) + gv[bj][1] * acc[ai][bj][m][1]));
    }
};

template <class E> struct Epi1 { E e;
    __device__ __forceinline__ void operator()(const f32x4 (&acc)[2][2][4][2], const gg::Unit& u, int wr, int wc, int fr, int fq) const {
#pragma unroll
        for (int ai = 0; ai < 2; ++ai)
#pragma unroll
            for (int m = 0; m < 4; ++m) {
#pragma unroll
              for (int bj = 0; bj < 2; ++bj) e.chunk(u, 128 * ai + 64 * wr + 16 * m + fr, 128 * bj + 32 * wc + 8 * fq, acc[ai][bj][m][0], acc[ai][bj][m][1]);
              asm volatile("" ::: "memory"); }
    } };
template <class E> struct EpiPairB { E e;
    __device__ __forceinline__ void operator()(const f32x4 (&acc)[2][2][4][2], const gg::Unit& u, int wr, int wc, int fr, int fq) const {
#pragma unroll
        for (int ai = 0; ai < 2; ++ai)
#pragma unroll
            for (int m = 0; m < 4; ++m) { e.chunk2(u, 128 * ai + 64 * wr + 16 * m + fr, 32 * wc + 8 * fq, acc[ai][0][m][0], acc[ai][0][m][1], acc[ai][1][m][0], acc[ai][1][m][1]);
              asm volatile("" ::: "memory"); }
    } };
struct EpiGluDrv { EpiGLU e;
    __device__ __forceinline__ void operator()(const f32x4 (&acc)[2][2][4][2], const gg::Unit& u, int wr, int wc, int fr, int fq) const {
        const int c = 32 * wc + 8 * fq, col = u.pn * 128 + c;
        const f32x4 ba0 = *(const f32x4*)(e.ba + col), ba1 = *(const f32x4*)(e.ba + col + 4), bb0 = *(const f32x4*)(e.bb + col), bb1 = *(const f32x4*)(e.bb + col + 4);
#pragma unroll
        for (int ai = 0; ai < 2; ++ai)
#pragma unroll
            for (int m = 0; m < 4; ++m) { e.chunk2b(u, 128 * ai + 64 * wr + 16 * m + fr, c, acc[ai][0][m][0], acc[ai][0][m][1], acc[ai][1][m][0], acc[ai][1][m][1], ba0, ba1, bb0, bb1);
              asm volatile("" ::: "memory"); }
    } };
template <class E> struct EpiPairA { E e;
    __device__ __forceinline__ void operator()(const f32x4 (&acc)[2][2][4][2], const gg::Unit& u, int wr, int wc, int fr, int fq) const {
#pragma unroll
        for (int m = 0; m < 4; ++m)
#pragma unroll
            for (int bj = 0; bj < 2; ++bj) { e.chunk2(u, 64 * wr + 16 * m + fr, 128 * bj + 32 * wc + 8 * fq, acc[0][bj][m][0], acc[0][bj][m][1], acc[1][bj][m][0], acc[1][bj][m][1]);
              asm volatile("" ::: "memory"); }
    } };

HD gg::Gemm gemm_S(unsigned char* ws)  { return gg::Gemm{(const char*)(ws + WS_UH), (const char*)(ws + WS_SB), 1024u, 512u, 4}; }
HD gg::Gemm gemm_Y(unsigned char* ws)  { return gg::Gemm{(const char*)(ws + WS_UH), (const char*)(ws + WS_KC), 1024u, 1024u, 8}; }
HD gg::Gemm gemm_F1(unsigned char* ws) { return gg::Gemm{(const char*)(ws + WS_WCS), (const char*)(ws + WS_ZF), (unsigned)(FHD * 2), (unsigned)(FW * 2), 8}; }
HD gg::Gemm gemm_F2(unsigned char* ws) { return gg::Gemm{(const char*)(ws + WS_F1), (const char*)(ws + WS_X1), 512u, 512u, 4}; }
HD gg::Gemm gemm_GLU(unsigned char* ws) { gg::Gemm g{(const char*)(ws + WS_G), (const char*)(ws + WS_WGLU), 32u, 2048u * 2u, 2048 / 64};
    g.csa = (unsigned)MTOK * 32u; g.ksa = (size_t)4 * MTOK * 32; return g; }
HD gg::Gemm gemm_F3(unsigned char* ws) { return gg::Gemm{(const char*)(ws + WS_F2), (const char*)(ws + WS_X2), 1024u, 1024u, 8}; }

struct cpx { float r, i; };
HD cpx cmul(cpx a, cpx b) { return cpx{a.r * b.r - a.i * b.i, a.r * b.i + a.i * b.r}; }
HD cpx cexp_f(float re, float im) {
    const float k = rintf(im * 0.15915494309189535f);
    float rr = fmaf(-k, 6.2831854820251465f, im); rr = fmaf(-k, -1.7484555314695172e-7f, rr);
    float s, c; sincos_rev(rr * 0.15915494309189535f, s, c);
    const float m = expf(re); return cpx{m * c, m * s};
}
struct S5P { float lr, li, dt; };
HD S5P s5_param(const float* lam_re, const float* lam_im, const float* log_dt, int dir, int g, int p) {
    S5P q; q.dt = expf(log_dt[dir * SG + g]); q.lr = fminf(lam_re[(dir * SG + g) * SP + p], -1e-4f); q.li = lam_im[(dir * SG + g) * SP + p]; return q;
}
HD cpx s5_pow(const S5P& q, float n) { return cexp_f(q.lr * q.dt * n, q.li * q.dt * n); }
HD cpx s5_coef(const S5P& q) {
    const cpx lb = s5_pow(q, 1.f); const float nr = lb.r - 1.f, ni = lb.i, den = 1.f / (q.lr * q.lr + q.li * q.li);
    return cpx{(nr * q.lr + ni * q.li) * den, (ni * q.lr - nr * q.li) * den};
}

typedef GAS unsigned gu32;
#define RLX_AGENT __ATOMIC_RELAXED, __HIP_MEMORY_SCOPE_AGENT
#define LDS_WAIT() asm volatile("s_waitcnt lgkmcnt(0)" ::: "memory")
#define VM_WAIT() asm volatile("s_waitcnt vmcnt(0)" ::: "memory")

#define XB_TMO      128
#define XB_XCNT(j)  (256  + 64 * (j))
#define XB_XSUB(j)  (1280 + 64 * (j))
#define XB_XGEN(j)  (2304 + 64 * (j))
#define XB_TOP      3328
#define XB_TOPGEN   3392
#define XCD_BAR_WORDS 3456
#define XB_SPIN_CAP (1u << 18)
__device__ __forceinline__ unsigned xb_ld(unsigned* p)              { return __hip_atomic_load(p, __ATOMIC_RELAXED, __HIP_MEMORY_SCOPE_AGENT); }
__device__ __forceinline__ unsigned xb_add(unsigned* p, unsigned v) { return __hip_atomic_fetch_add(p, v, __ATOMIC_RELAXED, __HIP_MEMORY_SCOPE_AGENT); }
__device__ __forceinline__ unsigned xb_xcc_id() { return (unsigned)__builtin_amdgcn_s_getreg((3 << 11) | 20) & 0xFu; }
#define XB_SPIN(cond, bar) do { unsigned _sp = 0; while (cond) { __builtin_amdgcn_s_sleep(1); \
    if ((++_sp & 255u) == 0u) { if (xb_ld(&(bar)[XB_TMO])) break; if (_sp > XB_SPIN_CAP) { atomicAdd(&(bar)[XB_TMO], 1u); break; } } } } while (0)
struct XcdBarrier { unsigned* bar; unsigned x; volatile LAS unsigned* st; };
__device__ __forceinline__ XcdBarrier xcd_barrier_post(unsigned* bar, volatile LAS unsigned* st) {
    XcdBarrier b; b.bar = bar; b.x = xb_xcc_id(); b.st = st;
    if (threadIdx.x == 0) (void)xb_add(&bar[XB_XCNT(b.x)], 1u);
    return b;
}
__device__ __forceinline__ void xcd_barrier_complete(unsigned* bar, unsigned x, unsigned& nloc, unsigned& nx) {
    const unsigned G = gridDim.x * gridDim.y * gridDim.z;
    unsigned sum, cnt, mine, sp = 0u;
    for (;;) {
        sum = 0u; cnt = 0u; mine = 0u;
#pragma unroll
        for (unsigned j = 0; j < 16; ++j) { const unsigned c = xb_ld(&bar[XB_XCNT(j)]); sum += c; cnt += (c > 0u) ? 1u : 0u; mine = (j == x) ? c : mine; }
        if (sum == G) break;
        __builtin_amdgcn_s_sleep(1);
        if ((++sp & 255u) == 0u) { if (xb_ld(&bar[XB_TMO])) break; if (sp > XB_SPIN_CAP) { atomicAdd(&bar[XB_TMO], 1u); break; } }
    }
    nloc = mine > 0u ? mine : 1u; nx = cnt > 0u ? cnt : 1u;
}
__device__ __forceinline__ void xcd_barrier(const XcdBarrier& b) {
    asm volatile("s_waitcnt vmcnt(0)" ::: "memory");
    __syncthreads();
    if (threadIdx.x == 0) {
        unsigned* bar = b.bar;
        __builtin_amdgcn_s_waitcnt(0);
        unsigned nloc = b.st[0], nx = b.st[1];
        if (nloc == 0u) { xcd_barrier_complete(bar, b.x, nloc, nx); b.st[0] = nloc; b.st[1] = nx; }
        const unsigned old = xb_add(&bar[XB_XSUB(b.x)], 1u);
        const unsigned gen = old / nloc;
        if (old + 1u == (gen + 1u) * nloc) {
            __builtin_amdgcn_fence(__ATOMIC_RELEASE, "agent");
            asm volatile("s_waitcnt vmcnt(0)" ::: "memory");
            const unsigned og = xb_add(&bar[XB_TOP], 1u);
            const unsigned tg = og / nx;
            if (og + 1u == (tg + 1u) * nx) xb_add(&bar[XB_TOPGEN], 1u);
            else XB_SPIN(xb_ld(&bar[XB_TOPGEN]) == tg, bar);
            __builtin_amdgcn_fence(__ATOMIC_ACQUIRE, "agent");
            xb_add(&bar[XB_XGEN(b.x)], 1u);
            asm volatile("s_waitcnt vmcnt(0)" ::: "memory");
        } else {
            XB_SPIN(xb_ld(&bar[XB_XGEN(b.x)]) == gen, bar);
            __builtin_amdgcn_fence(__ATOMIC_ACQUIRE, "agent");
            asm volatile("s_waitcnt vmcnt(0)" ::: "memory");
        }
    }
    __syncthreads();
}

struct Args { const float* in[27]; float* out; unsigned char* ws; int ph_lo, ph_hi; };
struct Frame { LAS unsigned char* lds; volatile LAS unsigned* MISC; gu32* ctl; int tid, lane, wave, vcu, G; };
__device__ __forceinline__ float wave_sum(float v) {
#pragma unroll
    for (int o = 1; o < 64; o <<= 1) v += __shfl_xor(v, o);
    return v;
}

__device__ __forceinline__ void transpose_item64(const float* W, int K, int N, bf16* WT, int k0, int n0, int drow0, LAS bf16* T, int lane) {
    const int r4 = lane >> 4, cg = lane & 15;
    f32x4 v[16];
    const float* wp = W + (size_t)(k0 + 8 * r4) * N + n0 + 4 * cg;
#pragma unroll
    for (int i = 0; i < 16; ++i) v[i] = *(const GAS f32x4*)(wp + (size_t)(32 * (i >> 3) + (i & 7)) * N);
#pragma unroll
    for (int q = 0; q < 2; ++q)
#pragma unroll
        for (int j = 0; j < 4; ++j) {
            u32x4 w; w.x = gg::cvt_pk_bf16(v[8 * q + 0][j], v[8 * q + 1][j]); w.y = gg::cvt_pk_bf16(v[8 * q + 2][j], v[8 * q + 3][j]);
            w.z = gg::cvt_pk_bf16(v[8 * q + 4][j], v[8 * q + 5][j]); w.w = gg::cvt_pk_bf16(v[8 * q + 6][j], v[8 * q + 7][j]);
            *(LAS u32x4*)(T + (4 * cg + j) * 72 + 32 * q + 8 * r4) = w;
        }
    LDS_WAIT(); asm volatile("" ::: "memory");
    const int kc = lane & 7, nl = lane >> 3;
#pragma unroll
    for (int ps = 0; ps < 8; ++ps) { const int n = 8 * ps + nl; const u32x4 w = *(const LAS u32x4*)(T + n * 72 + 8 * kc);
        *(GAS u32x4*)(WT + (size_t)(drow0 + n) * K + k0 + 8 * kc) = w; }
    LDS_WAIT(); asm volatile("" ::: "memory");
}
template <bool ILV>
__device__ __forceinline__ void transpose_matrix(const Frame& F, const float* W, int K, int N, bf16* WT, int ilv_half, int& item_base, int gw, int NGW) {
    LAS bf16* T = (LAS bf16*)(F.lds + RING_OFF + F.wave * 16384);
    const int nblk = N / 64, nitems = (K / 64) * nblk;
    const int first = (gw - (item_base % NGW) + NGW) % NGW;
    for (int it = first; it < nitems; it += NGW) {
        const int kb = it / nblk, nb = it % nblk, k0 = 64 * kb, n0 = 64 * nb;
        const int drow0 = ILV ? (256 * (n0 >> 7) + 128 * ilv_half + (n0 & 127)) : n0;
        transpose_item64(W, K, N, WT, k0, n0, drow0, T, F.lane);
    }
    item_base += nitems;
}

__device__ __forceinline__ void ada_phase(const Frame& F, const float* c, const float* cctx, const float* ada_w, const float* ada_b, float* mod) {
    LAS float* sv = (LAS float*)(F.lds + RING_OFF);
    LAS float* red = (LAS float*)(F.lds + RING_OFF + 49152);
    for (int i = F.tid; i < 3 * DM; i += NWAVES * 64) { const int v = i / DM, k = i % DM; const float x = v < 2 ? c[v * DM + k] : cctx[k]; sv[i] = silu_f(x); }
    __syncthreads();
    const int NCOL = 6 * DM;
    for (int blk = F.vcu; blk < NCOL / 96; blk += F.G) {
        const int n0 = blk * 96;
        const int cg = F.tid % 24, rs = F.tid / 24;
        f32x4 a0 = {0.f, 0.f, 0.f, 0.f}, a1 = a0, a2 = a0;
        if (rs < 21) {
            const float* wp = ada_w + n0 + 4 * cg;
#pragma unroll 8
            for (int k = rs; k < DM; k += 21) {
                const f32x4 w = *(const f32x4*)(wp + (size_t)k * NCOL);
                a0 += w * sv[k]; a1 += w * sv[DM + k]; a2 += w * sv[2 * DM + k];
            }
            LAS float* r = red + (rs * 3) * 96 + 4 * cg;
            *(LAS f32x4*)(r) = a0; *(LAS f32x4*)(r + 96) = a1; *(LAS f32x4*)(r + 192) = a2;
        }
        __syncthreads();
        if (F.tid < 288) {
            const int v = F.tid / 96, n = F.tid % 96; float s = 0.f;
            for (int r = 0; r < 21; ++r) s += red[(r * 3 + v) * 96 + n];
            mod[(size_t)v * NCOL + n0 + n] = s + ada_b[n0 + n];
        }
        __syncthreads();
    }
}

__device__ __forceinline__ void norm_mod_row(const float* xrow, const float* g, const float* sh, const float* sc, bf16* orow, int lane, bf16* xcopy = nullptr) {
    const GAS f32x4* xr = (const GAS f32x4*)xrow + lane;
    f32x4 v[16]; float s = 0.f;
#pragma unroll
    for (int j = 0; j < 16; ++j) { v[j] = xr[64 * j]; s += (v[j].x * v[j].x + v[j].y * v[j].y) + (v[j].z * v[j].z + v[j].w * v[j].w); }
    if (xcopy) { GAS u32x2* c8 = (GAS u32x2*)xcopy + lane;
#pragma unroll
        for (int j = 0; j < 16; ++j) { u32x2 w; w.x = gg::cvt_pk_bf16(v[j].x, v[j].y); w.y = gg::cvt_pk_bf16(v[j].z, v[j].w); c8[64 * j] = w; } }
    const float rstd = 1.f / sqrtf(wave_sum(s) * (1.f / DM) + EPS);
    GAS u32x2* o8 = (GAS u32x2*)orow + lane;
#pragma unroll
    for (int j = 0; j < 16; ++j) {
        const int col = 4 * (lane + 64 * j);
        const f32x4 gg_ = *(const f32x4*)(g + col), shv = *(const f32x4*)(sh + col), scv = *(const f32x4*)(sc + col);
        const f32x4 y = (v[j] * rstd) * gg_ * (scv + 1.f) + shv;
        u32x2 w; w.x = pk2(y.x, y.y); w.y = pk2(y.z, y.w); o8[64 * j] = w;
    }
}
__device__ __forceinline__ void norm_mod_row_b(const bf16* xrow, const float* g, const float* sh, const float* sc, bf16* orow, int lane) {
    const GAS u32x4* xr = (const GAS u32x4*)xrow + lane;
    f32x4 v[8][2]; float s = 0.f;
#pragma unroll
    for (int j = 0; j < 8; ++j) { const u32x4 w = xr[64 * j]; v[j][0] = bf4lo(w); v[j][1] = bf4hi(w);
#pragma unroll
        for (int t = 0; t < 2; ++t) s += (v[j][t].x * v[j][t].x + v[j][t].y * v[j][t].y) + (v[j][t].z * v[j][t].z + v[j][t].w * v[j][t].w); }
    const float rstd = 1.f / sqrtf(wave_sum(s) * (1.f / DM) + EPS);
    GAS u32x4* o = (GAS u32x4*)orow + lane;
#pragma unroll
    for (int j = 0; j < 8; ++j) { const int col = 8 * (lane + 64 * j); f32x4 y[2];
#pragma unroll
        for (int t = 0; t < 2; ++t) { const f32x4 gg_ = *(const f32x4*)(g + col + 4 * t), shv = *(const f32x4*)(sh + col + 4 * t), scv = *(const f32x4*)(sc + col + 4 * t); y[t] = (v[j][t] * rstd) * gg_ * (scv + 1.f) + shv; }
        o[64 * j] = gg::pack8(y[0], y[1]); }
}
__device__ __forceinline__ void stage_mod_lds(const Frame& F, LAS float* P, const float* g, const float* sh, const float* sc, int set) {
    for (int i = F.tid * 4; i < DM; i += NWAVES * 64 * 4) {
        const f32x4 gv = *(const f32x4*)(g + i), sv = *(const f32x4*)(sc + i), hv = *(const f32x4*)(sh + i);
        *(LAS f32x4*)(P + set * 2 * DM + i) = gv * (sv + 1.f); *(LAS f32x4*)(P + set * 2 * DM + DM + i) = hv; }
}
__device__ __forceinline__ void norm_mod_row_lds(const float* xrow, const LAS float* gm, const LAS float* shl, bf16* orow, int lane, bf16* xcopy) {
    const GAS f32x4* xr = (const GAS f32x4*)xrow + lane;
    f32x4 v[16]; float s = 0.f;
#pragma unroll
    for (int j = 0; j < 16; ++j) { v[j] = xr[64 * j]; s += (v[j].x * v[j].x + v[j].y * v[j].y) + (v[j].z * v[j].z + v[j].w * v[j].w); }
    if (xcopy) { GAS u32x2* c8 = (GAS u32x2*)xcopy + lane;
#pragma unroll
        for (int j = 0; j < 16; ++j) { u32x2 w; w.x = gg::cvt_pk_bf16(v[j].x, v[j].y); w.y = gg::cvt_pk_bf16(v[j].z, v[j].w); c8[64 * j] = w; } }
    const float rstd = 1.f / sqrtf(wave_sum(s) * (1.f / DM) + EPS);
    GAS u32x2* o8 = (GAS u32x2*)orow + lane;
#pragma unroll
    for (int j = 0; j < 16; ++j) { const int col = 4 * (lane + 64 * j);
        const f32x4 y = (v[j] * rstd) * *(const LAS f32x4*)(gm + col) + *(const LAS f32x4*)(shl + col);
        u32x2 w; w.x = gg::cvt_pk_bf16(y.x, y.y); w.y = gg::cvt_pk_bf16(y.z, y.w); o8[64 * j] = w; }
}
__device__ __forceinline__ void norm_mod_row_b_lds(const bf16* xrow, const LAS float* gm, const LAS float* shl, bf16* orow, int lane) {
    const GAS u32x4* xr = (const GAS u32x4*)xrow + lane;
    u32x4 w[8]; float s = 0.f;
#pragma unroll
    for (int j = 0; j < 8; ++j) { w[j] = xr[64 * j]; const f32x4 a = bf4lo(w[j]), b = bf4hi(w[j]); s += (a.x * a.x + a.y * a.y) + (a.z * a.z + a.w * a.w) + (b.x * b.x + b.y * b.y) + (b.z * b.z + b.w * b.w); }
    const float rstd = 1.f / sqrtf(wave_sum(s) * (1.f / DM) + EPS);
    GAS u32x4* o = (GAS u32x4*)orow + lane;
#pragma unroll
    for (int j = 0; j < 8; ++j) { const int col = 8 * (lane + 64 * j);
        const f32x4 y0 = (bf4lo(w[j]) * rstd) * *(const LAS f32x4*)(gm + col) + *(const LAS f32x4*)(shl + col), y1 = (bf4hi(w[j]) * rstd) * *(const LAS f32x4*)(gm + col + 4) + *(const LAS f32x4*)(shl + col + 4);
        o[64 * j] = gg::pack8(y0, y1); }
}
__device__ __forceinline__ void norm_row_b2f_load(const bf16* xrow, int lane, u32x2 (&w)[16]) {
    const GAS u32x2* xr = (const GAS u32x2*)xrow + lane;
#pragma unroll
    for (int j = 0; j < 16; ++j) w[j] = xr[64 * j];
}
__device__ __forceinline__ void norm_row_b2f_finish(const u32x2 (&w)[16], const LAS float* gl, float* orow, int lane) {
    float s = 0.f;
#pragma unroll
    for (int j = 0; j < 16; ++j) { const float a0 = __builtin_bit_cast(float, w[j].x << 16), a1 = __builtin_bit_cast(float, w[j].x & 0xffff0000u), a2 = __builtin_bit_cast(float, w[j].y << 16), a3 = __builtin_bit_cast(float, w[j].y & 0xffff0000u);
        s += (a0 * a0 + a1 * a1) + (a2 * a2 + a3 * a3); }
    const float rstd = 1.f / sqrtf(wave_sum(s) * (1.f / DM) + EPS);
#pragma unroll
    for (int j = 0; j < 16; ++j) { const int col = 4 * lane + 256 * j;
        f32x4 v; v.x = __builtin_bit_cast(float, w[j].x << 16); v.y = __builtin_bit_cast(float, w[j].x & 0xffff0000u); v.z = __builtin_bit_cast(float, w[j].y << 16); v.w = __builtin_bit_cast(float, w[j].y & 0xffff0000u);
        *(GAS f32x4*)(orow + col) = (v * rstd) * *(const LAS f32x4*)(gl + col); }
}
__device__ __forceinline__ void norm_row_b2f(const bf16* xrow, const float* g, float* orow, int lane) {
    const GAS u32x4* xr = (const GAS u32x4*)xrow + lane;
    f32x4 v[8][2]; float s = 0.f;
#pragma unroll
    for (int j = 0; j < 8; ++j) { const u32x4 w = xr[64 * j]; v[j][0] = bf4lo(w); v[j][1] = bf4hi(w);
#pragma unroll
        for (int t = 0; t < 2; ++t) s += (v[j][t].x * v[j][t].x + v[j][t].y * v[j][t].y) + (v[j][t].z * v[j][t].z + v[j][t].w * v[j][t].w); }
    const float rstd = 1.f / sqrtf(wave_sum(s) * (1.f / DM) + EPS);
#pragma unroll
    for (int j = 0; j < 8; ++j) { const int col = 8 * (lane + 64 * j);
#pragma unroll
        for (int t = 0; t < 2; ++t) *(GAS f32x4*)(orow + col + 4 * t) = (v[j][t] * rstd) * *(const f32x4*)(g + col + 4 * t); }
}
__device__ __forceinline__ void norm_row_f32(const float* xrow, const float* g, float* orow, int lane) {
    const GAS f32x4* xr = (const GAS f32x4*)xrow + lane;
    f32x4 v[16]; float s = 0.f;
#pragma unroll
    for (int j = 0; j < 16; ++j) { v[j] = xr[64 * j]; s += (v[j].x * v[j].x + v[j].y * v[j].y) + (v[j].z * v[j].z + v[j].w * v[j].w); }
    const float rstd = 1.f / sqrtf(wave_sum(s) * (1.f / DM) + EPS);
    GAS f32x4* o = (GAS f32x4*)orow + lane;
#pragma unroll
    for (int j = 0; j < 16; ++j) { const int col = 4 * (lane + 64 * j); o[64 * j] = (v[j] * rstd) * *(const f32x4*)(g + col); }
}

__device__ __forceinline__ void dft_tables(const Frame& F, bf16* F1, bf16* F2, float* TW) {
    const int gt = F.vcu * (NWAVES * 64) + F.tid, NT = F.G * NWAVES * 64;
    for (int i = gt; i < 256 * 256; i += NT) {
        const int row = i >> 8, col = i & 255, rp = row >> 7, k1 = row & 127, ri = col >> 7, ls = col & 127;
        float s, c; sincos_rev((float)((k1 * ls) & 127) * (1.f / 128.f), s, c);
        const float v = (rp == ri) ? c : (rp == 0 ? s : -s);
        F1[i] = (bf16)f2bf(v);
    }
    for (int i = gt; i < 256 * 512; i += NT) {
        const int row = i >> 9, col = i & 511, j = row >> 6, k2 = row & 63, jp = col >> 7, ri = (col >> 6) & 1, lf = col & 63;
        float s, c; sincos_rev((float)((k2 * lf) & 63) * (1.f / 64.f), s, c);
        F2[i] = (bf16)f2bf(j == jp ? (ri == 0 ? c : s) : 0.f);
    }
    for (int i = gt; i < 8192; i += NT) { float s, c; sincos_rev((float)i * (1.f / 8192.f), s, c); TW[2 * i] = c; TW[2 * i + 1] = -s; }
}
__device__ __forceinline__ void wcs_phase(const Frame& F, const float* fw, bf16* Wcs) {
    LAS float* cs = (LAS float*)(F.lds + RING_OFF);
    for (int i = F.tid; i < 512; i += NWAVES * 64) { float s, c; sincos_rev((float)i * (1.f / 512.f), s, c); cs[2 * i] = c; cs[2 * i + 1] = s; }
    __syncthreads();
    const int gw = F.vcu * NWAVES + F.wave, NGW = F.G * NWAVES;
    for (int it = gw; it < FH * 8 * 64; it += NGW) {
        const int h = it >> 9, db = (it >> 6) & 7, eb = it & 63, d = db * 64 + F.lane, e0 = eb * 8;
        float ac[8], as[8];
#pragma unroll
        for (int j = 0; j < 8; ++j) { ac[j] = 0.f; as[j] = 0.f; }
        const float* wp = fw + (size_t)h * FHD * FHD + e0;
#pragma unroll 2
        for (int m = 0; m < FHD; ++m) {
            const int idx = (m * d) & 511; const float c = cs[2 * idx], s = cs[2 * idx + 1];
            const f32x4 w0 = *(const f32x4*)(wp + (size_t)m * FHD), w1 = *(const f32x4*)(wp + (size_t)m * FHD + 4);
#pragma unroll
            for (int j = 0; j < 4; ++j) { ac[j] += c * w0[j]; as[j] += s * w0[j]; ac[4 + j] += c * w1[j]; as[4 + j] += s * w1[j]; }
        }
        bf16* o = Wcs + (size_t)h * 1024 * FHD + d;
#pragma unroll
        for (int j = 0; j < 8; ++j) { o[(size_t)(e0 + j) * FHD] = (bf16)f2bf(ac[j] * (1.f / 2048.f)); o[(size_t)(512 + e0 + j) * FHD] = (bf16)f2bf(-as[j] * (1.f / 2048.f)); }
    }
}
__device__ __forceinline__ void s5_matrices(const Frame& F, const float* const* in, bf16* SBm, bf16* KCm);

enum { IN_X = 0, IN_C, IN_CTX, IN_CCTX, IN_ADAW, IN_ADAB, IN_N1G, IN_N2G, IN_WIN, IN_WOUT, IN_FW, IN_LRE, IN_LIM, IN_LDT, IN_BRE, IN_BIM, IN_CRE, IN_CIM, IN_SD,
       IN_GWA, IN_GBA, IN_GWB, IN_GBB, IN_WG, IN_WU, IN_WD, IN_FG };

template <class P2, class PF> struct S5TabT { P2 LP, Bb, Cc; PF Kt, dsk; };
template <class P2> HD cpx ldc(P2 p, int i) { const f32x2 v = p[i]; return cpx{v.x, v.y}; }
template <class TT> HD float sb_entry(const TT& T, int row, int col) {
    const int dir = row >> 7, p = (row >> 1) & 63, ri = row & 1, j = col >> 4, hi = col & 15, e = dir == 0 ? 15 - j : j;
    const cpx t = cmul(ldc(T.LP, (dir * 17 + e) * 64 + p), ldc(T.Bb, (dir * 64 + p) * 16 + hi)); return ri == 0 ? t.r : t.i;
}
template <class TT> HD float kc_entry(const TT& T, int row, int col) {
    const int jo = row >> 4, ho = row & 15;
    if (col < 256) { const int i = col >> 4, hi = col & 15;
        if (i < jo) return T.Kt[((0 * 16 + (jo - i)) * 16 + ho) * 16 + hi];
        if (i > jo) return T.Kt[((1 * 16 + (i - jo)) * 16 + ho) * 16 + hi];
        return T.Kt[((0 * 16 + 0) * 16 + ho) * 16 + hi] + T.Kt[((1 * 16 + 0) * 16 + ho) * 16 + hi] + (ho == hi ? T.dsk[ho] : 0.f); }
    const int cc = col - 256, dir = cc >> 7, p = (cc >> 1) & 63, ri = cc & 1, e = dir == 0 ? jo + 1 : 16 - jo;
    const cpx t = cmul(ldc(T.Cc, (dir * 16 + ho) * 64 + p), ldc(T.LP, (dir * 17 + e) * 64 + p)); return ri == 0 ? t.r : -t.i;
}

__device__ __forceinline__ void s5_matrices(const Frame& F, const float* const* in, bf16* SBm, bf16* KCm) {
    LAS f32x2* LP = (LAS f32x2*)(F.lds + RING_OFF);
    LAS f32x2* Bb = (LAS f32x2*)(F.lds + RING_OFF + 17408);
    LAS f32x2* Cc = (LAS f32x2*)(F.lds + RING_OFF + 33792);
    LAS float* Kt = (LAS float*)(F.lds + RING_OFF + 50176);
    LAS float* dsk = (LAS float*)(F.lds + RING_OFF + 82944);
    for (int it = F.vcu; it < SG * 2; it += F.G) {
        const int g = it >> 1, half = it & 1;
        __syncthreads();
        if (F.tid < 128) { const int dir = F.tid >> 6, p = F.tid & 63; const S5P q = s5_param(in[IN_LRE], in[IN_LIM], in[IN_LDT], dir, g, p);
            for (int n = 0; n <= 16; ++n) { const cpx v = s5_pow(q, (float)n); LP[(dir * 17 + n) * 64 + p] = (f32x2){v.r, v.i}; } }
        if (F.tid >= 128 && F.tid < 144) dsk[F.tid - 128] = in[IN_SD][g * 16 + (F.tid - 128)];
        for (int i = F.tid; i < 2 * 64 * 16; i += NWAVES * 64) { const int dir = i >> 10, p = (i >> 4) & 63, h = i & 15;
            const S5P q = s5_param(in[IN_LRE], in[IN_LIM], in[IN_LDT], dir, g, p); const cpx cf = s5_coef(q);
            const size_t bi = (((size_t)dir * SG + g) * SP + p) * SH + h; const cpx v = cmul(cf, cpx{in[IN_BRE][bi], in[IN_BIM][bi]}); Bb[i] = (f32x2){v.r, v.i};
            const int ho = (i >> 6) & 15, pp = i & 63; const size_t ci = (((size_t)dir * SG + g) * SH + ho) * SP + pp; Cc[i] = (f32x2){in[IN_CRE][ci], in[IN_CIM][ci]}; }
        __syncthreads();
        {
            const int dir = F.tid >> 8, tau = (F.tid >> 4) & 15, ho = F.tid & 15; float a[16];
#pragma unroll
            for (int h = 0; h < 16; ++h) a[h] = 0.f;
            for (int p = 0; p < 64; ++p) { const f32x2 c = Cc[(dir * 16 + ho) * 64 + p], l = LP[(dir * 17 + tau) * 64 + p]; const cpx t = cpx{c.x * l.x - c.y * l.y, c.x * l.y + c.y * l.x};
#pragma unroll
                for (int h = 0; h < 16; ++h) { const f32x2 b = Bb[(dir * 64 + p) * 16 + h]; a[h] += t.r * b.x - t.i * b.y; } }
#pragma unroll
            for (int h = 0; h < 16; ++h) Kt[((dir * 16 + tau) * 16 + ho) * 16 + h] = a[h];
        }
        __syncthreads();
        const S5TabT<const LAS f32x2*, const LAS float*> T{LP, Bb, Cc, Kt, dsk};
        bf16* sb = SBm + (size_t)g * 256 * 256 + (size_t)half * 128 * 256; bf16* kc = KCm + (size_t)g * 256 * 512 + (size_t)half * 128 * 512;
        for (int ck = F.tid; ck < 128 * 256 / 8; ck += NWAVES * 64) { const int row = half * 128 + (ck >> 5), c0 = (ck & 31) * 8; u32x4 w;
            w.x = pk2(sb_entry(T, row, c0), sb_entry(T, row, c0 + 1)); w.y = pk2(sb_entry(T, row, c0 + 2), sb_entry(T, row, c0 + 3));
            w.z = pk2(sb_entry(T, row, c0 + 4), sb_entry(T, row, c0 + 5)); w.w = pk2(sb_entry(T, row, c0 + 6), sb_entry(T, row, c0 + 7));
            *(u32x4*)(sb + (size_t)(ck >> 5) * 256 + c0) = w; }
        for (int ck = F.tid; ck < 128 * 512 / 8; ck += NWAVES * 64) { const int row = half * 128 + (ck >> 6), c0 = (ck & 63) * 8; u32x4 w;
            w.x = pk2(kc_entry(T, row, c0), kc_entry(T, row, c0 + 1)); w.y = pk2(kc_entry(T, row, c0 + 2), kc_entry(T, row, c0 + 3));
            w.z = pk2(kc_entry(T, row, c0 + 4), kc_entry(T, row, c0 + 5)); w.w = pk2(kc_entry(T, row, c0 + 6), kc_entry(T, row, c0 + 7));
            *(u32x4*)(kc + (size_t)(ck >> 6) * 512 + c0) = w; }
    }
    __syncthreads();
}

__device__ __forceinline__ void ctx_gemm(const Frame& F, const bf16* HnCtx, const bf16* WinS5, float* Zc) {
    LAS float* part = (LAS float*)(F.lds + RING_OFF);
    const int fr = F.lane & 15, fq = F.lane >> 4;
    for (int t = F.vcu; t < (MCTX / 64) * (2048 / 64); t += F.G) {
        const int mt = t >> 5, ntile = t & 31;
        f32x4 acc[4][4];
#pragma unroll
        for (int a = 0; a < 4; ++a)
#pragma unroll
            for (int b = 0; b < 4; ++b) acc[a][b] = (f32x4){0.f, 0.f, 0.f, 0.f};
        const bf16* ap = HnCtx + (size_t)(mt * 64 + fr) * DM + F.wave * 64 + fq * 16;
        const bf16* bp = WinS5 + (size_t)(ntile * 64 + fr) * DM + F.wave * 64 + fq * 16;
#define CTX_LD(af_, bf_, k_) do { _Pragma("unroll") for (int kk = 0; kk < 2; ++kk) _Pragma("unroll") for (int a = 0; a < 4; ++a) { \
            af_[kk][a] = *(const bf16x8*)(ap + (size_t)a * 16 * DM + ((k_) >> 1) * 512 + kk * 8); bf_[kk][a] = *(const bf16x8*)(bp + (size_t)a * 16 * DM + ((k_) >> 1) * 512 + kk * 8); } } while (0)
#define CTX_MM(af_, bf_) do { _Pragma("unroll") for (int kk = 0; kk < 2; ++kk) _Pragma("unroll") for (int a = 0; a < 4; ++a) _Pragma("unroll") for (int b = 0; b < 4; ++b) \
            acc[a][b] = __builtin_amdgcn_mfma_f32_16x16x32_bf16(bf_[kk][b], af_[kk][a], acc[a][b], 0, 0, 0); } while (0)
        {
            bf16x8 af0[2][4], bf0[2][4], af1[2][4], bf1[2][4];
            CTX_LD(af0, bf0, 0);
#pragma unroll
            for (int k = 0; k < 16; k += 4) {
                CTX_LD(af1, bf1, k + 2);
                CTX_MM(af0, bf0);
                if (k + 4 < 16) CTX_LD(af0, bf0, k + 4);
                CTX_MM(af1, bf1);
            }
        }
#undef CTX_LD
#undef CTX_MM
        __syncthreads();
#pragma unroll
        for (int a = 0; a < 4; ++a)
#pragma unroll
            for (int b = 0; b < 4; ++b) *(LAS f32x4*)(part + ((size_t)F.wave * 64 + a * 16 + fr) * 64 + ((b * 16 + 4 * fq) ^ (fr * 4))) = acc[a][b];
        __syncthreads();
        for (int i = F.tid; i < 64 * 64 / 4; i += NWAVES * 64) { const int r = i >> 4, c4 = (i & 15) * 4, sw = r * 64 + (c4 ^ ((r & 15) * 4));
            f32x4 s = *(LAS f32x4*)(part + sw);
#pragma unroll
            for (int w = 1; w < 8; ++w) s += *(LAS f32x4*)(part + (size_t)w * 4096 + sw); *(f32x4*)(Zc + (size_t)(mt * 64 + r) * 2048 + ntile * 64 + c4) = s; }
        __syncthreads();
    }
}

__device__ __forceinline__ void carry_phase(const Frame& F, const float* const* in, const float* Zc, const bf16* Sst, bf16* UH, const bf16* SBm) {
    LAS float* uc = (LAS float*)(F.lds + RING_OFF);
    LAS bf16* Sbuf = (LAS bf16*)(F.lds + RING_OFF + 32768);
    LAS bf16* Hbuf = (LAS bf16*)(F.lds + RING_OFF + 65536);
    LAS float* Scx = (LAS float*)(F.lds + RING_OFF + 65536);
    for (int bg = F.vcu; bg < NB * SG; bg += F.G) {
        const int b = bg / SG, g = bg % SG;
        __syncthreads();
        const int fr = F.lane & 15, fq = F.lane >> 4;
        bf16x8 sbf[2][8];
        { const bf16* sp = SBm + (size_t)g * 65536 + (size_t)(F.wave * 32 + fr) * 256 + fq * 8;
#pragma unroll
          for (int nb = 0; nb < 2; ++nb)
#pragma unroll
              for (int s = 0; s < 8; ++s) sbf[nb][s] = *(const bf16x8*)(sp + nb * 16 * 256 + s * 32); }
        { const int s = F.tid >> 1, hf = F.tid & 1; const float* zp = Zc + (size_t)(b * CTXL + s) * 2048 + g * 16 + hf * 8; LAS float* up = uc + (s >> 4) * 260 + (s & 15) * 16 + hf * 8;
          *(LAS f32x4*)up = *(const f32x4*)zp; *(LAS f32x4*)(up + 4) = *(const f32x4*)(zp + 4); }
        __syncthreads();
        {
            f32x4 acc[2] = {(f32x4){0.f, 0.f, 0.f, 0.f}, (f32x4){0.f, 0.f, 0.f, 0.f}};
#pragma unroll
            for (int s = 0; s < 8; ++s) {
                const f32x4 u0 = *(LAS f32x4*)(uc + fr * 260 + s * 32 + fq * 8), u1 = *(LAS f32x4*)(uc + fr * 260 + s * 32 + fq * 8 + 4);
                const bf16x8 af = __builtin_bit_cast(bf16x8, gg::pack8(u0, u1));
#pragma unroll
                for (int nb = 0; nb < 2; ++nb) acc[nb] = __builtin_amdgcn_mfma_f32_16x16x32_bf16(sbf[nb][s], af, acc[nb], 0, 0, 0);
            }
#pragma unroll
            for (int nb = 0; nb < 2; ++nb) *(LAS f32x4*)(Scx + fr * 260 + F.wave * 32 + nb * 16 + 4 * fq) = acc[nb];
        }
        __syncthreads();
        const int dir = F.wave & 1, seg = F.wave >> 1, p = F.lane;
        const S5P q = s5_param(in[IN_LRE], in[IN_LIM], in[IN_LDT], dir, g, p);
        cpx H{0.f, 0.f}; const cpx l16 = s5_pow(q, 16.f);
        if (seg == 0) {
#pragma unroll
            for (int cc = 0; cc < 16; ++cc) { const int c = dir == 0 ? cc : 15 - cc; const f32x2 sv = *(LAS f32x2*)(Scx + c * 260 + dir * 128 + 2 * p);
                H = cpx{__builtin_fmaf(l16.r, H.r, __builtin_fmaf(-l16.i, H.i, sv.x)), __builtin_fmaf(l16.r, H.i, __builtin_fmaf(l16.i, H.r, sv.y))}; }
        }
        const bf16* sbase = Sst + ((size_t)g * 1024 + (size_t)b * NCH) * 256;
        bf16* hbase = UH + ((size_t)g * 1024 + (size_t)b * NCH) * 512 + 256;
#define CARRY_SRC(pc_, i_) (sbase + (size_t)((((F.tid + (i_) * 512) >> 10) == 0) ? 64 * (pc_) + (((F.tid + (i_) * 512) >> 4) & 63) : NCH - 1 - 64 * (pc_) - (((F.tid + (i_) * 512) >> 4) & 63)) * 256 + ((F.tid + (i_) * 512) >> 10) * 128 + ((F.tid + (i_) * 512) & 15) * 8)
        u32x4 pre[4];
#pragma unroll
        for (int i = 0; i < 4; ++i) pre[i] = *(const u32x4*)CARRY_SRC(0, i);
        for (int pc = 0; pc < 8; ++pc) {
#pragma unroll
            for (int i = 0; i < 4; ++i) { const int id = F.tid + i * 512, d = id >> 10, ci = (id >> 4) & 63, part = id & 15; *(LAS u32x4*)(Sbuf + (d * 64 + ci) * 128 + part * 8) = pre[i]; }
            if (pc + 1 < 8) {
#pragma unroll
                for (int i = 0; i < 4; ++i) pre[i] = *(const u32x4*)CARRY_SRC(pc + 1, i);
            }
            __syncthreads();
            if (seg == 0) {
                LAS unsigned* Sw = (LAS unsigned*)Sbuf + dir * 64 * 64 + p; LAS unsigned* Hw = (LAS unsigned*)Hbuf + dir * 64 * 64 + p;
#pragma unroll 8
                for (int ci = 0; ci < 64; ++ci) {
                    Hw[ci * 64] = gg::cvt_pk_bf16(H.r, H.i);
                    const unsigned sv = Sw[ci * 64];
                    const float sr = __builtin_bit_cast(float, sv << 16), si = __builtin_bit_cast(float, sv & 0xffff0000u);
                    H = cpx{__builtin_fmaf(l16.r, H.r, __builtin_fmaf(-l16.i, H.i, sr)), __builtin_fmaf(l16.r, H.i, __builtin_fmaf(l16.i, H.r, si))};
                }
            }
            __syncthreads();
#pragma unroll
            for (int i = 0; i < 4; ++i) { const int id = F.tid + i * 512, d = id >> 10, ci = (id >> 4) & 63, part = id & 15;
                const int chn = d == 0 ? 64 * pc + ci : NCH - 1 - 64 * pc - ci;
                *(u32x4*)(hbase + (size_t)chn * 512 + d * 128 + part * 8) = *(LAS u32x4*)(Hbuf + (d * 64 + ci) * 128 + part * 8); }
        }
#undef CARRY_SRC
    }
    __syncthreads();
}

constexpr int NPHASE = 12;
#ifndef MK_FOURIER
#define MK_FOURIER 1
#endif

__global__ void __launch_bounds__(NWAVES * 64, 2) mk_fwd(Args args) {
    extern __shared__ __attribute__((aligned(16))) unsigned char lds[];
    Frame F;
    F.lds = (LAS unsigned char*)lds;
    F.MISC = (volatile LAS unsigned*)(F.lds + MISC_OFF);
    F.tid = threadIdx.x; F.lane = F.tid & 63; F.wave = __builtin_amdgcn_readfirstlane(F.tid >> 6);
    F.G = gridDim.x; { const int bx = blockIdx.x; F.vcu = (F.G % 8 == 0) ? (bx % 8) * (F.G / 8) + bx / 8 : bx; }
    unsigned char* ws = args.ws;
    F.ctl = (gu32*)(ws + WS_CTL);
    for (int u = F.tid; u < (LDS_BYTES - LDSCTL_OFF) / 4; u += NWAVES * 64) ((LAS unsigned*)(F.lds + LDSCTL_OFF))[u] = 0u;
    __syncthreads();
    XcdBarrier bar; bar.bar = (unsigned*)(F.ctl + CW_BAR); bar.x = 0; bar.st = nullptr;
    if (!MK_PER_PHASE) bar = xcd_barrier_post((unsigned*)(F.ctl + CW_BAR), F.MISC + 8);
#define GRID_BAR() do { if (MK_PER_PHASE) { if (F.tid == 0) __hip_atomic_store(F.ctl + CW_TMO, 0xBADBA0u, RLX_AGENT); } else { xcd_barrier(bar); } } while (0)
    const int lo = args.ph_lo, hi = args.ph_hi;
#ifndef MK_PHASE_MASK
#define MK_PHASE_MASK 0xFFFF
#endif
#define IN(k) (((MK_PHASE_MASK >> (k)) & 1) && lo <= (k) && (k) < hi)
#define BOTH(k) (IN(k) && IN((k) + 1))
#ifndef MK_DUP
#define MK_DUP (-1)
#endif
#define REP(k) _Pragma("unroll") for (int rep_ = 0; rep_ < ((MK_DUP == (k)) ? 2 : 1); ++rep_)

    float* mod = (float*)(ws + WS_MOD);
    bf16* Win_t = (bf16*)(ws + WS_WIN); bf16* Wout_t = (bf16*)(ws + WS_WOUT); bf16* Wglu_t = (bf16*)(ws + WS_WGLU);
    bf16* Wgu_t = (bf16*)(ws + WS_WGU); bf16* Wdn_t = (bf16*)(ws + WS_WDN);
    bf16* Hn = (bf16*)(ws + WS_HN); bf16* Hid = (bf16*)(ws + WS_HID); bf16* CAT = (bf16*)(ws + WS_CAT); bf16* Gb = (bf16*)(ws + WS_G);
    bf16* ZF = (bf16*)(ws + WS_ZF); bf16* UH = (bf16*)(ws + WS_UH); bf16* Sst = (bf16*)(ws + WS_SST);
    float* Zc = (float*)(ws + WS_ZC); bf16* XR = (bf16*)(ws + WS_XR);
    const float* x = args.in[IN_X];
    float* out = args.out;
    const int gw = F.vcu * NWAVES + F.wave, NGW = F.G * NWAVES;

    if (IN(0)) { REP(0) {
#define P0_MEM() do { int ib = 0; \
        transpose_matrix<false>(F, args.in[IN_WIN], DM, DM, Win_t, 0, ib, gw, NGW); \
        transpose_matrix<false>(F, args.in[IN_WOUT], DM, DM, Wout_t, 0, ib, gw, NGW); \
        transpose_matrix<true>(F, args.in[IN_GWA], 2048, 2048, Wglu_t, 0, ib, gw, NGW); \
        transpose_matrix<true>(F, args.in[IN_GWB], 2048, 2048, Wglu_t, 1, ib, gw, NGW); \
        transpose_matrix<true>(F, args.in[IN_WG], DM, FFN, Wgu_t, 0, ib, gw, NGW); \
        transpose_matrix<true>(F, args.in[IN_WU], DM, FFN, Wgu_t, 1, ib, gw, NGW);         \
        __syncthreads(); \
        ada_phase(F, args.in[IN_C], args.in[IN_CCTX], args.in[IN_ADAW], args.in[IN_ADAB], mod); } while (0)
#define P0_CMP() do { dft_tables(F, (bf16*)(ws + WS_F1), (bf16*)(ws + WS_F2), (float*)(ws + WS_TW)); \
        wcs_phase(F, args.in[IN_FW], (bf16*)(ws + WS_WCS)); \
        s5_matrices(F, args.in, (bf16*)(ws + WS_SB), (bf16*)(ws + WS_KC)); } while (0)
        if (F.vcu & 1) { P0_MEM(); __syncthreads(); P0_CMP(); } else { P0_CMP(); __syncthreads(); P0_MEM(); }
#undef P0_MEM
#undef P0_CMP
        }
        if (BOTH(0)) GRID_BAR();
    }
    if (IN(1)) { REP(1) {
        { LAS float* P = (LAS float*)(F.lds + RING_OFF);
          __syncthreads();
          stage_mod_lds(F, P, args.in[IN_N1G], mod, mod + DM, 0); stage_mod_lds(F, P, args.in[IN_N1G], mod + (size_t)6 * DM, mod + (size_t)6 * DM + DM, 1);
          stage_mod_lds(F, P, args.in[IN_N1G], mod + (size_t)12 * DM, mod + (size_t)12 * DM + DM, 2);
          __syncthreads();
          for (int m = gw; m < MTOK + MCTX; m += NGW) {
              if (m < MTOK) { const int b = m / SEQ; norm_mod_row_lds(x + (size_t)m * DM, P + b * 2 * DM, P + b * 2 * DM + DM, Hn + (size_t)m * DM, F.lane, XR + (size_t)m * DM); }
              else norm_mod_row_lds(args.in[IN_CTX] + (size_t)(m - MTOK) * DM, P + 2 * 2 * DM, P + 2 * 2 * DM + DM, Hn + (size_t)m * DM, F.lane, nullptr);
          }
          __syncthreads(); }
        }
        if (BOTH(1)) GRID_BAR();
    }
    if (IN(2)) { REP(2) {
        gg::Gemm g{(const char*)Hn, (const char*)Win_t, DM * 2, DM * 2, DM / 64};
        gg::Order2D S; S.init(MTOK / 256, DM / 256, F.G, (int)blockIdx.x, g.lda, g.ldb);
        Epi1<EpiZ> E{EpiZ{ZF, UH}};
        gg::gemm_phase<Epi1<EpiZ>, gg::Order2D, true>(F.lds + RING_OFF, g, S, E);
        REP(21) ctx_gemm(F, Hn + (size_t)MTOK * DM, Win_t + (size_t)FW * DM, Zc);
        }
        if (BOTH(2)) GRID_BAR();
    }
    if (IN(3)) { {
        REP(30) { const gg::Gemm g = gemm_S(ws); gg::OrderS5 S{F.G, (int)blockIdx.x, (size_t)256 * 256 * 2}; Epi1<EpiS> E{EpiS{Sst}};
          gg::gemm_phase<Epi1<EpiS>, gg::OrderS5, true>(F.lds + RING_OFF, g, S, E); }
#if MK_FOURIER
        REP(31) { const gg::Gemm g = gemm_F1(ws); gg::OrderF1 S{F.G, (int)blockIdx.x}; Epi1<EpiF1> E{EpiF1{(bf16*)(ws + WS_X1)}};
          gg::gemm_phase<Epi1<EpiF1>, gg::OrderF1, true>(F.lds + RING_OFF, g, S, E); }
#endif
        }
        if (BOTH(3)) GRID_BAR();
    }
    if (IN(4)) { {
        REP(40) carry_phase(F, args.in, Zc, Sst, UH, (const bf16*)(ws + WS_SB));
#if MK_FOURIER
        REP(41) { const gg::Gemm g = gemm_F2(ws); gg::OrderLin S{1024, F.G, (int)blockIdx.x, (size_t)256 * 512}; EpiPairA<EpiF2> E{EpiF2{(bf16*)(ws + WS_X2), (const float*)(ws + WS_TW)}};
          gg::gemm_phase<EpiPairA<EpiF2>, gg::OrderLin, true>(F.lds + RING_OFF, g, S, E); }
#endif
        }
        if (BOTH(4)) GRID_BAR();
    }
    if (IN(5)) { {
        REP(50) { const gg::Gemm g = gemm_Y(ws); gg::OrderS5 S{F.G, (int)blockIdx.x, (size_t)256 * 512 * 2}; Epi1<EpiY> E{EpiY{Gb}};
          gg::gemm_phase<Epi1<EpiY>, gg::OrderS5, true>(F.lds + RING_OFF, g, S, E); }
#if MK_FOURIER
        REP(51) { const gg::Gemm g = gemm_F3(ws); gg::OrderLin S{512, F.G, (int)blockIdx.x, (size_t)256 * 1024}; Epi1<EpiF3> E{EpiF3{CAT}};
          gg::gemm_phase<Epi1<EpiF3>, gg::OrderLin, true, true>(F.lds + RING_OFF, g, S, E); }
#endif
        }
        if (BOTH(5)) GRID_BAR();
    }
    if (IN(6)) { REP(6) {
        gg::Gemm g = gemm_GLU(ws);
        gg::Order2D S; S.init(MTOK / 256, 4096 / 256, F.G, (int)blockIdx.x, g.lda, g.ldb);
        EpiGluDrv E{EpiGLU{CAT, args.in[IN_GBA], args.in[IN_GBB]}};
        gg::gemm_phase<EpiGluDrv, gg::Order2D, true>(F.lds + RING_OFF, g, S, E);
        }
        if (BOTH(6)) GRID_BAR();
    }
    if (IN(7)) { REP(7) {
#if MK_FOURIER
        gg::Gemm g{(const char*)CAT, (const char*)Wout_t, DM * 2, DM * 2, DM / 64};
#else
        gg::Gemm g{(const char*)(CAT + FW), (const char*)(Wout_t + FW), DM * 2, DM * 2, FW / 64};
#endif
        gg::Order2D S; S.init(MTOK / 256, DM / 256, F.G, (int)blockIdx.x, g.lda, g.ldb);
        EpiResidB E{XR, mod + 2 * DM, 6 * DM};
        gg::gemm_phase<EpiResidB, gg::Order2D, true>(F.lds + RING_OFF, g, S, E);
        }
        if (BOTH(7)) GRID_BAR();
    }
    if (IN(8)) { REP(8) {
        { LAS float* P = (LAS float*)(F.lds + RING_OFF);
          __syncthreads();
          stage_mod_lds(F, P, args.in[IN_N2G], mod + 3 * DM, mod + 4 * DM, 0); stage_mod_lds(F, P, args.in[IN_N2G], mod + (size_t)6 * DM + 3 * DM, mod + (size_t)6 * DM + 4 * DM, 1);
          __syncthreads();
          for (int m = gw; m < MTOK; m += NGW) { const int b = m / SEQ; norm_mod_row_b_lds(XR + (size_t)m * DM, P + b * 2 * DM, P + b * 2 * DM + DM, Hn + (size_t)m * DM, F.lane); }
          __syncthreads(); }
        }
        if (BOTH(8)) GRID_BAR();
    }
    if (IN(9)) { REP(9) {
        gg::Gemm g{(const char*)Hn, (const char*)Wgu_t, DM * 2, DM * 2, DM / 64};
        gg::Order2D S; S.init(MTOK / 256, 2 * FFN / 256, F.G, (int)blockIdx.x, g.lda, g.ldb);
        EpiPairB<EpiSwiGLU> E{EpiSwiGLU{Hid}};
        gg::gemm_phase<EpiPairB<EpiSwiGLU>, gg::Order2D, true>(F.lds + RING_OFF, g, S, E);
        {
            const int rem = S.nwg % F.G, c = (int)blockIdx.x;
            if (rem == 0 || c >= rem) { int ib2 = 0; transpose_matrix<false>(F, args.in[IN_WD], FFN, DM, Wdn_t, 0, ib2, ((rem == 0 ? c : c - rem) * NWAVES + F.wave), (rem == 0 ? F.G : F.G - rem) * NWAVES); }
        }
        }
        if (BOTH(9)) GRID_BAR();
    }
    if (IN(10)) {
        gg::Gemm g{(const char*)Hid, (const char*)Wdn_t, FFN * 2, FFN * 2, FFN / 64};
        gg::Order2D S; S.init(MTOK / 256, DM / 256, F.G, (int)blockIdx.x, g.lda, g.ldb);
        EpiResidB E{XR, mod + 5 * DM, 6 * DM};
        gg::gemm_phase<EpiResidB, gg::Order2D, true>(F.lds + RING_OFF, g, S, E);
        if (BOTH(10)) GRID_BAR();
    }
    if (IN(11)) {
        const bool poison = (__hip_atomic_load(F.ctl + CW_TMO, RLX_AGENT) != 0u) || (__hip_atomic_load((gu32*)((unsigned*)(F.ctl + CW_BAR) + XB_TMO), RLX_AGENT) != 0u);
        LAS float* gl = (LAS float*)(F.lds + RING_OFF);
        __syncthreads();
        for (int i = F.tid * 4; i < DM; i += NWAVES * 64 * 4) *(LAS f32x4*)(gl + i) = *(const f32x4*)(args.in[IN_FG] + i);
        __syncthreads();
        u32x2 wc_[16], wn_[16];
        if (gw < MTOK) norm_row_b2f_load(XR + (size_t)gw * DM, F.lane, wc_);
        for (int m = gw; m < MTOK; m += NGW) {
            const bool more = m + NGW < MTOK;
            if (more) norm_row_b2f_load(XR + (size_t)(m + NGW) * DM, F.lane, wn_);
            norm_row_b2f_finish(wc_, gl, out + (size_t)m * DM, F.lane);
            if (poison && F.lane == 0) out[(size_t)m * DM] = __builtin_nanf("");
            if (more) {
#pragma unroll
                for (int j = 0; j < 16; ++j) wc_[j] = wn_[j];
            }
        }
    }
#undef IN
#undef BOTH
}

extern "C" void kernel_launch(void* const* d_in, const int* in_sizes, int n_in, void* d_out, int out_size, void* d_ws, size_t ws_size, hipStream_t stream) {
    static int grid = 0;
    if (grid == 0) {
        if (n_in != 27 || out_size != MTOK * DM || ws_size < WS_END) { fprintf(stderr, "kernel_launch: unexpected shapes (n_in %d out %d ws %zu need %zu)\n", n_in, out_size, ws_size, (size_t)WS_END); grid = -1; return; }
        int dev = 0, cus = 0, per_cu = 0;
        if (hipGetDevice(&dev) != hipSuccess || hipDeviceGetAttribute(&cus, hipDeviceAttributeMultiprocessorCount, dev) != hipSuccess) { grid = -1; return; }
        if (hipFuncSetAttribute((const void*)mk_fwd, hipFuncAttributeMaxDynamicSharedMemorySize, LDS_BYTES) != hipSuccess) { fprintf(stderr, "kernel_launch: hipFuncSetAttribute failed\n"); grid = -1; return; }
        if (hipOccupancyMaxActiveBlocksPerMultiprocessor(&per_cu, (const void*)mk_fwd, NWAVES * 64, LDS_BYTES) != hipSuccess || per_cu < 1)
            fprintf(stderr, "kernel_launch: occupancy query reports %d\n", per_cu);
        (void)hipGetLastError();
        grid = cus;
    }
    if (grid < 0) return;
    (void)in_sizes;
    if (hipMemsetAsync((char*)d_ws + WS_CTL, 0, CTL_ZERO_BYTES, stream) != hipSuccess) return;
    Args a{};
    for (int i = 0; i < 27; ++i) a.in[i] = (const float*)d_in[i];
    a.out = (float*)d_out; a.ws = (unsigned char*)d_ws;
#if MK_PER_PHASE
    for (int p = 0; p < NPHASE; ++p) { a.ph_lo = p; a.ph_hi = p + 1; hipLaunchKernelGGL(mk_fwd, dim3(grid), dim3(NWAVES * 64), LDS_BYTES, stream, a); }
#else
    a.ph_lo = 0; a.ph_hi = NPHASE;
    hipLaunchKernelGGL(mk_fwd, dim3(grid), dim3(NWAVES * 64), LDS_BYTES, stream, a);
#endif
}
```

```cpp
#include <hip/hip_runtime.h>
#include <cstdio>
#include <cstdint>
#include <cmath>

#define LAS __attribute__((address_space(3)))
#define GAS __attribute__((address_space(1)))
#define HD __host__ __device__ __forceinline__
typedef unsigned short bf16;
typedef short bf16x8 __attribute__((ext_vector_type(8)));
typedef float f32x4 __attribute__((ext_vector_type(4)));
typedef float f32x2 __attribute__((ext_vector_type(2)));
typedef unsigned u32x4 __attribute__((ext_vector_type(4)));
typedef unsigned u32x2 __attribute__((ext_vector_type(2)));

constexpr int DM = 4096, NB = 2, SEQ = 8192, CTXL = 256, FFN = 11008;
constexpr int MTOK = NB * SEQ;
constexpr int MCTX = NB * CTXL;
constexpr int FW = 2048, FH = 4, FHD = 512;
constexpr int SG = 128, SH = 16, SP = 64;
constexpr int CH = 16, NCH = SEQ / CH;
constexpr int LS = 128, LF = 64;
constexpr float EPS = 1e-6f;

#ifndef MK_PER_PHASE
#define MK_PER_PHASE 0
#endif

HD unsigned f2bf(float f) { unsigned u = __builtin_bit_cast(unsigned, f); return (u + 0x7fffu + ((u >> 16) & 1u)) >> 16; }
HD unsigned pk2(float lo, float hi) { return f2bf(lo) | (f2bf(hi) << 16); }
HD float bf2f(bf16 b) { return __builtin_bit_cast(float, (unsigned)b << 16); }

namespace gg {
constexpr int BM = 256, BK = 64, HALF = 128, HTB = HALF * BK * 2, STAGE_BYTES = 8 * HTB, NXCD = 8, WGM = 8;
HD int lds_byte(int r, int c) { const int st = (r >> 4) * 2 + (c >> 5), rr = r & 15, cc = c & 31, ob = rr * 64 + cc * 2; return st * 1024 + (ob ^ (((ob >> 9) & 1) << 5)); }
HD void stage_rc(int b, int& R, int& C) { const int st = b / 1024, sb = b % 1024, swz = sb ^ (((sb >> 9) & 1) << 5); R = (st >> 1) * 16 + swz / 64; C = (st & 1) * 32 + (swz % 64) / 2; }
HD int perm32(int rho) { const int n = rho >> 4, i = rho & 15; return 8 * (i >> 2) + 4 * n + (i & 3); }

struct Unit { size_t aoff, boff; int pm, pn, z; };
struct Gemm { const char* A; const char* B; unsigned lda, ldb; int nt;
              unsigned csa = 32, csb = 32;
              size_t ksa = 128, ksb = 128; };
HD size_t elem_off(unsigned ld, unsigned cs, size_t ks, int r, int k) { return (size_t)r * ld + (size_t)(k >> 6) * ks + (size_t)((k & 63) >> 4) * cs + (size_t)(k & 15) * 2; }

struct Order2D {
    int nM, nN, nwg, G, c; size_t ta, tb;
    HD void init(int nM_, int nN_, int G_, int c_, unsigned lda, unsigned ldb) { nM = nM_; nN = nN_; nwg = nM * nN; G = G_; c = c_; ta = (size_t)BM * lda; tb = (size_t)BM * ldb; }
    HD bool next(int i, Unit& u) const {
        const long L = (long)i * G + c; if (L >= nwg) return false;
        int wgid = (int)L; { const int q = nwg / NXCD, r = nwg % NXCD, xcd = wgid % NXCD, off = wgid / NXCD; wgid = (xcd < r ? xcd * (q + 1) : r * (q + 1) + (xcd - r) * q) + off; }
        const int nig = WGM * nN, gid = wgid / nig, fm = gid * WGM, gsz = (nM - fm) < WGM ? (nM - fm) : WGM;
        u.pm = fm + ((wgid % nig) % gsz); u.pn = (wgid % nig) / gsz; u.z = 0; u.aoff = (size_t)u.pm * ta; u.boff = (size_t)u.pn * tb; return true;
    }
};
struct OrderS5 {
    int G, c; size_t bstride;
    HD bool next(int i, Unit& u) const {
        const int L = i * G + c; if (L >= SG * 4) return false;
        const int xcd = L & 7, q = L >> 3; u.pm = q & 3; u.z = (q >> 2) * 8 + xcd; u.pn = 0;
        u.aoff = ((size_t)u.z * 1024 + (size_t)u.pm * 256) * 1024; u.boff = (size_t)u.z * bstride; return true;
    }
};
struct OrderF1 {
    int G, c;
    HD bool next(int i, Unit& u) const {
        const int L = i * G + c; if (L >= FH * 4 * 64) return false;
        u.pn = L & 63; u.pm = (L >> 6) & 3; u.z = L >> 8;
        u.aoff = ((size_t)u.z * 1024 + (size_t)u.pm * 256) * (FHD * 2); u.boff = (size_t)u.pn * 256 * (FW * 2) + (size_t)u.z * (FHD * 2); return true;
    }
};
struct OrderLin {
    int n, G, c; size_t bstep;
    HD bool next(int i, Unit& u) const { const int L = i * G + c; if (L >= n) return false; u.pm = 0; u.pn = L; u.z = 0; u.aoff = 0; u.boff = (size_t)L * bstep; return true; }
};

HD unsigned cvt_pk_bf16(float lo, float hi) {
#if defined(__HIP_DEVICE_COMPILE__)
    unsigned r; asm volatile("v_cvt_pk_bf16_f32 %0, %1, %2" : "=v"(r) : "v"(lo), "v"(hi)); return r;
#else
    return pk2(lo, hi);
#endif
}
HD u32x4 pack8(const f32x4& v0, const f32x4& v1) { u32x4 w; w.x = cvt_pk_bf16(v0[0], v0[1]); w.y = cvt_pk_bf16(v0[2], v0[3]); w.z = cvt_pk_bf16(v1[0], v1[1]); w.w = cvt_pk_bf16(v1[2], v1[3]); return w; }

template <class Epi, class Sched, bool ALIGN_EPI, bool BD = false>
__device__ __forceinline__ void gemm_phase(LAS unsigned char* lds, const Gemm g, const Sched& S, const Epi& E) {
    const int tid = threadIdx.x, wid = __builtin_amdgcn_readfirstlane(tid >> 6), lane = tid & 63, wr = wid >> 2, wc = wid & 3, fr = lane & 15, fq = lane >> 4;
    int nt = g.nt; asm volatile("" : "+s"(nt));
    unsigned voffA[2], voffB[2];
#pragma unroll
    for (int i = 0; i < 2; ++i) { int R, C; stage_rc(tid * 16 + i * 8192, R, C); const int Rb = (R & ~31) + perm32(R & 31);
        voffA[i] = (unsigned)R * g.lda + (unsigned)(C >> 4) * g.csa + (unsigned)(C & 15) * 2u; voffB[i] = (unsigned)Rb * g.ldb + (unsigned)(C >> 4) * g.csb + (unsigned)(C & 15) * 2u; }
    const size_t kstepA = g.ksa, kstepB = g.ksb;
    const size_t hstepA = (size_t)HALF * g.lda, hstepB = (size_t)HALF * g.ldb;
    const unsigned ldsw = (unsigned)wid * 1024u;
    const int aoff = lds_byte(wr * 64 + fr, fq * 8), boff = lds_byte(wc * 32 + fr, fq * 8);
#define PG8_SA(b, h) (((b) * 2 + (h)) * HTB)
#define PG8_SB(b, h) ((4 + (b) * 2 + (h)) * HTB)
#define PG8_STAGE(bufoff, gbase, voff) do { _Pragma("unroll") for (int _i = 0; _i < 2; ++_i) \
        __builtin_amdgcn_global_load_lds((const unsigned*)((const char*)(gbase) + (voff)[_i]), (LAS unsigned*)(lds + (bufoff) + ldsw + _i * 8192), 16, 0, 0); } while (0)
#define PG8_LDA(dst, b, h) do { _Pragma("unroll") for (int m = 0; m < 4; ++m) _Pragma("unroll") for (int k = 0; k < 2; ++k) dst[m][k] = *(const LAS bf16x8*)(lds + PG8_SA(b, h) + aoff + m * 2048 + k * 1024); } while (0)
#define PG8_LDB(dst, b, h) do { _Pragma("unroll") for (int n = 0; n < 2; ++n) _Pragma("unroll") for (int k = 0; k < 2; ++k) dst[n][k] = *(const LAS bf16x8*)(lds + PG8_SB(b, h) + boff + n * 2048 + k * 1024); } while (0)
#define PG8_MMA(ai, bj, At, Bt) do { __builtin_amdgcn_s_setprio(1); _Pragma("unroll") for (int m = 0; m < 4; ++m) _Pragma("unroll") for (int n = 0; n < 2; ++n) _Pragma("unroll") for (int k = 0; k < 2; ++k) \
        acc[ai][bj][m][n] = __builtin_amdgcn_mfma_f32_16x16x32_bf16(Bt[n][k], At[m][k], acc[ai][bj][m][n], 0, 0, 0); __builtin_amdgcn_s_setprio(0); } while (0)
#define PG8_WAIT_V(n) asm volatile("s_waitcnt vmcnt(" #n ")" ::: "memory")
#define PG8_WAIT_L(n) asm volatile("s_waitcnt lgkmcnt(" #n ")" ::: "memory")
#define PG8_BAR __builtin_amdgcn_s_barrier()
#define PG8_SCHED __builtin_amdgcn_sched_barrier(0)
    Unit cur, nxt; int ui = 0;
    if (!S.next(0, cur)) return;
    f32x4 acc[2][2][4][2];
#pragma unroll
    for (int a = 0; a < 2; ++a)
#pragma unroll
        for (int b = 0; b < 2; ++b)
#pragma unroll
            for (int m = 0; m < 4; ++m)
#pragma unroll
                for (int n = 0; n < 2; ++n) acc[a][b][m][n] = (f32x4){0.f, 0.f, 0.f, 0.f};
    bf16x8 At[4][2], B0[2][2], B1[2][2];
    const char* cA = g.A + cur.aoff; const char* cB = g.B + cur.boff;
    PG8_STAGE(PG8_SB(0, 0), cB, voffB); PG8_STAGE(PG8_SB(0, 1), cB + hstepB, voffB); PG8_STAGE(PG8_SA(0, 0), cA, voffA); PG8_STAGE(PG8_SA(0, 1), cA + hstepA, voffA);
    if (wr == 1) PG8_BAR;
    PG8_WAIT_V(2); PG8_BAR;
    PG8_STAGE(PG8_SB(1, 0), cB + kstepB, voffB); PG8_STAGE(PG8_SA(1, 0), cA + kstepA, voffA); PG8_STAGE(PG8_SB(1, 1), cB + hstepB + kstepB, voffB);
    PG8_WAIT_V(6); PG8_BAR;
    for (;;) {
        const bool has_next = S.next(ui + 1, nxt);
        const char* nA = has_next ? g.A + nxt.aoff : cA; const char* nB = has_next ? g.B + nxt.boff : cB;
        for (int t = 0; t < nt; t += 2) {
            const bool last = (t == nt - 2);
            const char* a1 = cA + (size_t)(t + 1) * kstepA;
            const char* a2 = last ? nA : cA + (size_t)(t + 2) * kstepA; const char* b2 = last ? nB : cB + (size_t)(t + 2) * kstepB;
            const char* a3 = a2 + kstepA; const char* b3 = b2 + kstepB;
            const bool do0 = !BD || ((t >> 1) == wr), do1 = !BD || ((t >> 1) == 2 + wr);
            PG8_LDB(B0, 0, 0); PG8_LDB(B1, 0, 1); PG8_SCHED; PG8_LDA(At, 0, 0); PG8_STAGE(PG8_SA(1, 1), a1 + hstepA, voffA);
            PG8_WAIT_V(8); PG8_WAIT_L(0); PG8_BAR; if (do0) { PG8_MMA(0, 0, At, B0); PG8_MMA(0, 1, At, B1); } PG8_BAR; PG8_SCHED;
            PG8_LDA(At, 0, 1); PG8_STAGE(PG8_SB(0, 0), b2, voffB); PG8_STAGE(PG8_SB(0, 1), b2 + hstepB, voffB); PG8_STAGE(PG8_SA(0, 0), a2, voffA);
            PG8_WAIT_V(8); PG8_WAIT_L(0); PG8_BAR; if (do1) { PG8_MMA(1, 0, At, B0); PG8_MMA(1, 1, At, B1); } PG8_BAR; PG8_SCHED;
            PG8_LDB(B0, 1, 0); PG8_LDB(B1, 1, 1); PG8_SCHED; PG8_LDA(At, 1, 0); PG8_STAGE(PG8_SA(0, 1), a2 + hstepA, voffA);
            PG8_WAIT_V(8); PG8_WAIT_L(0); PG8_BAR; if (do0) { PG8_MMA(0, 0, At, B0); PG8_MMA(0, 1, At, B1); } PG8_BAR; PG8_SCHED;
            PG8_LDA(At, 1, 1); PG8_STAGE(PG8_SB(1, 0), b3, voffB); PG8_STAGE(PG8_SB(1, 1), b3 + hstepB, voffB); PG8_STAGE(PG8_SA(1, 0), a3, voffA);
            PG8_WAIT_V(8); PG8_WAIT_L(0); PG8_BAR; if (do1) { PG8_MMA(1, 0, At, B0); PG8_MMA(1, 1, At, B1); } PG8_BAR; PG8_SCHED;
        }
        if constexpr (ALIGN_EPI) { if (wr == 0) PG8_BAR; }
        { int fr2 = fr, fq2 = fq; asm volatile("" : "+v"(fr2), "+v"(fq2));
          E(acc, cur, wr, wc, fr2, fq2); }
        if (!has_next) break;
#pragma unroll
        for (int a = 0; a < 2; ++a)
#pragma unroll
            for (int b = 0; b < 2; ++b)
#pragma unroll
                for (int m = 0; m < 4; ++m)
#pragma unroll
                    for (int n = 0; n < 2; ++n) acc[a][b][m][n] = (f32x4){0.f, 0.f, 0.f, 0.f};
        cur = nxt; cA = nA; cB = nB; ++ui;
        if constexpr (ALIGN_EPI) { if (wr == 1) PG8_BAR; }
    }
    PG8_WAIT_V(0);
    if constexpr (!ALIGN_EPI) { if (wr == 0) PG8_BAR; }
    PG8_BAR;
#undef PG8_SA
#undef PG8_SB
#undef PG8_STAGE
#undef PG8_LDA
#undef PG8_LDB
#undef PG8_MMA
#undef PG8_WAIT_V
#undef PG8_WAIT_L
#undef PG8_BAR
#undef PG8_SCHED
}
}

constexpr size_t MiB = 1u << 20;
constexpr size_t WS_CTL = 0, CTL_ZERO_BYTES = 1 * MiB;
constexpr size_t WS_MOD  = 1 * MiB;
constexpr size_t WS_F1   = 2 * MiB;
constexpr size_t WS_F2   = 2 * MiB + 256 * 1024;
constexpr size_t WS_TW   = 3 * MiB;
constexpr size_t WS_ZC   = 4 * MiB;
constexpr size_t WS_WIN  = 8 * MiB;
constexpr size_t WS_WOUT = 40 * MiB;
constexpr size_t WS_WGLU = 72 * MiB;
constexpr size_t WS_WGU  = 88 * MiB;
constexpr size_t WS_WDN  = 260 * MiB;
constexpr size_t WS_WCS  = 346 * MiB;
constexpr size_t WS_SB   = 350 * MiB;
constexpr size_t WS_KC   = 366 * MiB;
constexpr size_t WS_HN   = 398 * MiB;
constexpr size_t WS_CAT  = 530 * MiB;
constexpr size_t WS_G    = 658 * MiB;
constexpr size_t WS_ZF   = 722 * MiB;
constexpr size_t WS_UH   = 786 * MiB;
constexpr size_t WS_SST  = 914 * MiB;
constexpr size_t WS_X1   = 978 * MiB;
constexpr size_t WS_X2   = 1106 * MiB;
constexpr size_t WS_HID  = 722 * MiB;
constexpr size_t WS_XR   = 1234 * MiB;
constexpr size_t WS_END  = 1362 * MiB;
static_assert(WS_HID + (size_t)MTOK * FFN * 2 <= WS_END, "ws map");
constexpr int CW_TMO = 0, CW_CODE = 1, CW_BAR = 4096;

constexpr int RING_OFF = 0, RING_BYTES = 131072;
constexpr int LDSCTL_OFF = RING_BYTES, MISC_OFF = LDSCTL_OFF + 320;
constexpr int LDS_BYTES = 147456;
constexpr int NWAVES = 8;

HD void sincos_rev(float rev, float& s, float& c) {
#if defined(__HIP_DEVICE_COMPILE__)
    s = __builtin_amdgcn_sinf(rev); c = __builtin_amdgcn_cosf(rev);
#else
    const double a = 6.283185307179586476925 * (double)rev; s = (float)sin(a); c = (float)cos(a);
#endif
}
HD void st16(bf16* p, const u32x4& w) { *(u32x4*)p = w; }
#if defined(__HIP_DEVICE_COMPILE__)
#define FEXP(x) __expf(x)
#else
#define FEXP(x) expf(x)
#endif
#if defined(__HIP_DEVICE_COMPILE__)
#define FRCP(x) __builtin_amdgcn_rcpf(x)
#else
#define FRCP(x) (1.f / (x))
#endif
HD float sigmoid_f(float x) { return FRCP(1.f + FEXP(-x)); }
HD float silu_f(float x) { return x * sigmoid_f(x); }
HD float gelu_tanh_f(float x) { const float t = 1.5957691216f * (x + 0.044715f * x * x * x); return x * sigmoid_f(t); }

struct EpiZ {
    bf16* ZF; bf16* UH;
    HD void chunk(const gg::Unit& u, int r, int c, const f32x4& v0, const f32x4& v1) const {
        const int row = u.pm * 256 + r, b = row >> 13, l = row & (SEQ - 1);
        if (u.pn < 8) { const int n = u.pn * 256 + c; const size_t rho = (size_t)b * SEQ + (size_t)(l & (LF - 1)) * LS + (l >> 6); st16(ZF + rho * FW + n, gg::pack8(v0, v1)); }
        else { const int n = (u.pn - 8) * 256 + c, g = n >> 4, h0 = n & 15;
            st16(UH + ((size_t)g * 1024 + (size_t)b * NCH + (l >> 4)) * 512 + (l & 15) * 16 + h0, gg::pack8(v0, v1)); }
    }
};
struct EpiS {
    bf16* Sst;
    HD void chunk(const gg::Unit& u, int r, int c, const f32x4& v0, const f32x4& v1) const { st16(Sst + ((size_t)u.z * 1024 + u.pm * 256 + r) * 256 + c, gg::pack8(v0, v1)); }
};
struct EpiY {
    bf16* Gb;
    HD void chunk(const gg::Unit& u, int r, int c, const f32x4& v0, const f32x4& v1) const {
        const int bc = u.pm * 256 + r, b = bc >> 9, ch = bc & (NCH - 1), jo = c >> 4, ho = c & 15;
        f32x4 a, d;
        for (int j = 0; j < 4; ++j) { a[j] = gelu_tanh_f(v0[j]); d[j] = gelu_tanh_f(v1[j]); }
        st16(Gb + (((size_t)u.z * MTOK + (size_t)b * SEQ + ch * CH + jo) * 16 + ho), gg::pack8(a, d));
    }
};
struct EpiGLU {
    bf16* CAT; const float* ba; const float* bb;
    HD void chunk2(const gg::Unit& u, int r, int c, const f32x4& a0, const f32x4& a1, const f32x4& b0, const f32x4& b1) const {
        const int col = u.pn * 128 + c;
        chunk2b(u, r, c, a0, a1, b0, b1, *(const f32x4*)(ba + col), *(const f32x4*)(ba + col + 4), *(const f32x4*)(bb + col), *(const f32x4*)(bb + col + 4));
    }
    HD void chunk2b(const gg::Unit& u, int r, int c, const f32x4& a0, const f32x4& a1, const f32x4& b0, const f32x4& b1, const f32x4& ba0, const f32x4& ba1, const f32x4& bb0, const f32x4& bb1) const {
        const int col = u.pn * 128 + c; f32x4 o0, o1;
        for (int j = 0; j < 4; ++j) { const float x0 = b0[j] + bb0[j], x1 = b1[j] + bb1[j];
            o0[j] = (a0[j] + ba0[j]) * sigmoid_f(x0); o1[j] = (a1[j] + ba1[j]) * sigmoid_f(x1); }
        st16(CAT + (size_t)(u.pm * 256 + r) * DM + FW + col, gg::pack8(o0, o1));
    }
};
struct EpiSwiGLU {
    bf16* Hid;
    HD void chunk2(const gg::Unit& u, int r, int c, const f32x4& g0, const f32x4& g1, const f32x4& u0, const f32x4& u1) const {
        f32x4 h0, h1;
        for (int j = 0; j < 4; ++j) { h0[j] = silu_f(g0[j]) * u0[j]; h1[j] = silu_f(g1[j]) * u1[j]; }
        st16(Hid + (size_t)(u.pm * 256 + r) * FFN + u.pn * 128 + c, gg::pack8(h0, h1));
    }
};
struct EpiF1 {
    bf16* X1;
    HD void chunk(const gg::Unit& u, int r, int c, const f32x4& v0, const f32x4& v1) const {
        const int rr = u.pm * 256 + r, ri = rr >> 9, e = rr & 511, n = u.pn * 256 + c, b = n >> 13, lf = (n >> 7) & (LF - 1), ls = n & (LS - 1);
        st16(X1 + ((((size_t)b * FH + u.z) * FHD + e) * LF + lf) * 256 + ri * LS + ls, gg::pack8(v0, v1));
    }
};
struct EpiF2 {
    bf16* X2; const float* TW;
    HD void chunk2(const gg::Unit& u, int k1, int c, const f32x4& r0, const f32x4& r1, const f32x4& i0, const f32x4& i1) const {
        const int n = u.pn * 256 + c, lf = n & (LF - 1), beh = n >> 6, b = beh >> 11, h = (beh >> 9) & 3, e = beh & 511;
        f32x4 or0, or1, oi0, oi1;
        for (int j = 0; j < 4; ++j) {
            float c0, s0, c1, s1; sincos_rev((float)(k1 * (lf + j)) * (1.f / 8192.f), s0, c0); sincos_rev((float)(k1 * (lf + 4 + j)) * (1.f / 8192.f), s1, c1); s0 = -s0; s1 = -s1;
            or0[j] = r0[j] * c0 - i0[j] * s0; oi0[j] = r0[j] * s0 + i0[j] * c0;
            or1[j] = r1[j] * c1 - i1[j] * s1; oi1[j] = r1[j] * s1 + i1[j] * c1;
        }
        bf16* row = X2 + ((((size_t)b * 32 + (k1 >> 2)) * FH + h) * FHD + e) * 512 + (k1 & 3) * 128 + lf;
        st16(row, gg::pack8(or0, or1)); st16(row + LF, gg::pack8(oi0, oi1));
    }
};
struct EpiF3 {
    bf16* CAT;
    HD void chunk(const gg::Unit& u, int r, int c, const f32x4& v0, const f32x4& v1) const {
        const int j = r >> 6, k2 = r & 63, n = u.pn * 256 + c, e = n & 511, h = (n >> 9) & 3, k1h = (n >> 11) & 31, b = n >> 16;
        const int k = 4 * k1h + j + LS * k2;
        st16(CAT + ((size_t)b * SEQ + k) * DM + h * FHD + e, gg::pack8(v0, v1));
    }
};
struct EpiResidX {
    const float* base; bf16* xr; const float* gate; int gstride;
    __device__ __forceinline__ void operator()(const f32x4 (&acc)[2][2][4][2], const gg::Unit& u, int wr, int wc, int fr, int fq) const {
        const int row0 = u.pm * 256 + 64 * wr + fr, col0 = u.pn * 256 + 32 * wc + 8 * fq; const float* gp = gate + (size_t)(row0 >> 13) * gstride + col0;
        f32x4 gv[2][2];
#pragma unroll
        for (int bj = 0; bj < 2; ++bj) { gv[bj][0] = *(const f32x4*)(gp + 128 * bj); gv[bj][1] = *(const f32x4*)(gp + 128 * bj + 4); }
#pragma unroll
        for (int ai = 0; ai < 2; ++ai) {
            f32x4 bv[4][2][2];
#pragma unroll
            for (int m = 0; m < 4; ++m)
#pragma unroll
                for (int bj = 0; bj < 2; ++bj) { const float* bp = base + (size_t)(row0 + 128 * ai + 16 * m) * DM + col0 + 128 * bj; bv[m][bj][0] = *(const f32x4*)bp; bv[m][bj][1] = *(const f32x4*)(bp + 4); }
#pragma unroll
            for (int m = 0; m < 4; ++m)
#pragma unroll
                for (int bj = 0; bj < 2; ++bj) st16(xr + (size_t)(row0 + 128 * ai + 16 * m) * DM + col0 + 128 * bj, gg::pack8(bv[m][bj][0] + gv[bj][0] * acc[ai][bj][m][0], bv[m][bj][1] + gv[bj][1] * acc[ai][bj][m][1]));
            asm volatile("" ::: "memory");
        }
    }
};
HD f32x4 bf4lo(const u32x4& w) { f32x4 v; v[0] = __builtin_bit_cast(float, w.x << 16); v[1] = __builtin_bit_cast(float, w.x & 0xffff0000u); v[2] = __builtin_bit_cast(float, w.y << 16); v[3] = __builtin_bit_cast(float, w.y & 0xffff0000u); return v; }
HD f32x4 bf4hi(const u32x4& w) { f32x4 v; v[0] = __builtin_bit_cast(float, w.z << 16); v[1] = __builtin_bit_cast(float, w.z & 0xffff0000u); v[2] = __builtin_bit_cast(float, w.w << 16); v[3] = __builtin_bit_cast(float, w.w & 0xffff0000u); return v; }
struct EpiResidB {
    bf16* xr; const float* gate; int gstride;
    __device__ __forceinline__ void operator()(const f32x4 (&acc)[2][2][4][2], const gg::Unit& u, int wr, int wc, int fr, int fq) const {
        const int row0 = u.pm * 256 + 64 * wr + fr, col0 = u.pn * 256 + 32 * wc + 8 * fq; const float* gp = gate + (size_t)(row0 >> 13) * gstride + col0;
        f32x4 gv[2][2];
#pragma unroll
        for (int bj = 0; bj < 2; ++bj) { gv[bj][0] = *(const f32x4*)(gp + 128 * bj); gv[bj][1] = *(const f32x4*)(gp + 128 * bj + 4); }
        u32x4 bv[2][4][2];
#pragma unroll
        for (int ai = 0; ai < 2; ++ai)
#pragma unroll
            for (int m = 0; m < 4; ++m)
#pragma unroll
                for (int bj = 0; bj < 2; ++bj) bv[ai][m][bj] = *(const u32x4*)(xr + (size_t)(row0 + 128 * ai + 16 * m) * DM + col0 + 128 * bj);
#pragma unroll
        for (int ai = 0; ai < 2; ++ai)
#pragma unroll
            for (int m = 0; m < 4; ++m)
#pragma unroll
                for (int bj = 0; bj < 2; ++bj) st16(xr + (size_t)(row0 + 128 * ai + 16 * m) * DM + col0 + 128 * bj, gg::pack8(bf4lo(bv[ai][m][bj]) + gv[bj][0] * acc[ai][bj][m][0], bf4hi(bv[ai][m][bj]) + gv[bj][1] * acc[ai][bj][m][1]));
    }
};

template <class E> struct Epi1 { E e;
    __device__ __forceinline__ void operator()(const f32x4 (&acc)[2][2][4][2], const gg::Unit& u, int wr, int wc, int fr, int fq) const {
#pragma unroll
        for (int ai = 0; ai < 2; ++ai)
#pragma unroll
            for (int m = 0; m < 4; ++m) {
#pragma unroll
              for (int bj = 0; bj < 2; ++bj) e.chunk(u, 128 * ai + 64 * wr + 16 * m + fr, 128 * bj + 32 * wc + 8 * fq, acc[ai][bj][m][0], acc[ai][bj][m][1]);
              asm volatile("" ::: "memory"); }
    } };
template <class E> struct EpiPairB { E e;
    __device__ __forceinline__ void operator()(const f32x4 (&acc)[2][2][4][2], const gg::Unit& u, int wr, int wc, int fr, int fq) const {
#pragma unroll
        for (int ai = 0; ai < 2; ++ai)
#pragma unroll
            for (int m = 0; m < 4; ++m) { e.chunk2(u, 128 * ai + 64 * wr + 16 * m + fr, 32 * wc + 8 * fq, acc[ai][0][m][0], acc[ai][0][m][1], acc[ai][1][m][0], acc[ai][1][m][1]);
              asm volatile("" ::: "memory"); }
    } };
struct EpiGluDrv { EpiGLU e;
    __device__ __forceinline__ void operator()(const f32x4 (&acc)[2][2][4][2], const gg::Unit& u, int wr, int wc, int fr, int fq) const {
        const int c = 32 * wc + 8 * fq, col = u.pn * 128 + c;
        const f32x4 ba0 = *(const f32x4*)(e.ba + col), ba1 = *(const f32x4*)(e.ba + col + 4), bb0 = *(const f32x4*)(e.bb + col), bb1 = *(const f32x4*)(e.bb + col + 4);
#pragma unroll
        for (int ai = 0; ai < 2; ++ai)
#pragma unroll
            for (int m = 0; m < 4; ++m) { e.chunk2b(u, 128 * ai + 64 * wr + 16 * m + fr, c, acc[ai][0][m][0], acc[ai][0][m][1], acc[ai][1][m][0], acc[ai][1][m][1], ba0, ba1, bb0, bb1);
              asm volatile("" ::: "memory"); }
    } };
template <class E> struct EpiPairA { E e;
    __device__ __forceinline__ void operator()(const f32x4 (&acc)[2][2][4][2], const gg::Unit& u, int wr, int wc, int fr, int fq) const {
#pragma unroll
        for (int m = 0; m < 4; ++m)
#pragma unroll
            for (int bj = 0; bj < 2; ++bj) { e.chunk2(u, 64 * wr + 16 * m + fr, 128 * bj + 32 * wc + 8 * fq, acc[0][bj][m][0], acc[0][bj][m][1], acc[1][bj][m][0], acc[1][bj][m][1]);
              asm volatile("" ::: "memory"); }
    } };

HD gg::Gemm gemm_S(unsigned char* ws)  { return gg::Gemm{(const char*)(ws + WS_UH), (const char*)(ws + WS_SB), 1024u, 512u, 4}; }
HD gg::Gemm gemm_Y(unsigned char* ws)  { return gg::Gemm{(const char*)(ws + WS_UH), (const char*)(ws + WS_KC), 1024u, 1024u, 8}; }
HD gg::Gemm gemm_F1(unsigned char* ws) { return gg::Gemm{(const char*)(ws + WS_WCS), (const char*)(ws + WS_ZF), (unsigned)(FHD * 2), (unsigned)(FW * 2), 8}; }
HD gg::Gemm gemm_F2(unsigned char* ws) { return gg::Gemm{(const char*)(ws + WS_F1), (const char*)(ws + WS_X1), 512u, 512u, 4}; }
HD gg::Gemm gemm_GLU(unsigned char* ws) { gg::Gemm g{(const char*)(ws + WS_G), (const char*)(ws + WS_WGLU), 32u, 2048u * 2u, 2048 / 64};
    g.csa = (unsigned)MTOK * 32u; g.ksa = (size_t)4 * MTOK * 32; return g; }
HD gg::Gemm gemm_F3(unsigned char* ws) { return gg::Gemm{(const char*)(ws + WS_F2), (const char*)(ws + WS_X2), 1024u, 1024u, 8}; }

struct cpx { float r, i; };
HD cpx cmul(cpx a, cpx b) { return cpx{a.r * b.r - a.i * b.i, a.r * b.i + a.i * b.r}; }
HD cpx cexp_f(float re, float im) {
    const float k = rintf(im * 0.15915494309189535f);
    float rr = fmaf(-k, 6.2831854820251465f, im); rr = fmaf(-k, -1.7484555314695172e-7f, rr);
    float s, c; sincos_rev(rr * 0.15915494309189535f, s, c);
    const float m = expf(re); return cpx{m * c, m * s};
}
struct S5P { float lr, li, dt; };
HD S5P s5_param(const float* lam_re, const float* lam_im, const float* log_dt, int dir, int g, int p) {
    S5P q; q.dt = expf(log_dt[dir * SG + g]); q.lr = fminf(lam_re[(dir * SG + g) * SP + p], -1e-4f); q.li = lam_im[(dir * SG + g) * SP + p]; return q;
}
HD cpx s5_pow(const S5P& q, float n) { return cexp_f(q.lr * q.dt * n, q.li * q.dt * n); }
HD cpx s5_coef(const S5P& q) {
    const cpx lb = s5_pow(q, 1.f); const float nr = lb.r - 1.f, ni = lb.i, den = 1.f / (q.lr * q.lr + q.li * q.li);
    return cpx{(nr * q.lr + ni * q.li) * den, (ni * q.lr - nr * q.li) * den};
}

typedef GAS unsigned gu32;
#define RLX_AGENT __ATOMIC_RELAXED, __HIP_MEMORY_SCOPE_AGENT
#define LDS_WAIT() asm volatile("s_waitcnt lgkmcnt(0)" ::: "memory")
#define VM_WAIT() asm volatile("s_waitcnt vmcnt(0)" ::: "memory")

#define XB_TMO      128
#define XB_XCNT(j)  (256  + 64 * (j))
#define XB_XSUB(j)  (1280 + 64 * (j))
#define XB_XGEN(j)  (2304 + 64 * (j))
#define XB_TOP      3328
#define XB_TOPGEN   3392
#define XCD_BAR_WORDS 3456
#define XB_SPIN_CAP (1u << 18)
__device__ __forceinline__ unsigned xb_ld(unsigned* p)              { return __hip_atomic_load(p, __ATOMIC_RELAXED, __HIP_MEMORY_SCOPE_AGENT); }
__device__ __forceinline__ unsigned xb_add(unsigned* p, unsigned v) { return __hip_atomic_fetch_add(p, v, __ATOMIC_RELAXED, __HIP_MEMORY_SCOPE_AGENT); }
__device__ __forceinline__ unsigned xb_xcc_id() { return (unsigned)__builtin_amdgcn_s_getreg((3 << 11) | 20) & 0xFu; }
#define XB_SPIN(cond, bar) do { unsigned _sp = 0; while (cond) { __builtin_amdgcn_s_sleep(1); \
    if ((++_sp & 255u) == 0u) { if (xb_ld(&(bar)[XB_TMO])) break; if (_sp > XB_SPIN_CAP) { atomicAdd(&(bar)[XB_TMO], 1u); break; } } } } while (0)
struct XcdBarrier { unsigned* bar; unsigned x; volatile LAS unsigned* st; };
__device__ __forceinline__ XcdBarrier xcd_barrier_post(unsigned* bar, volatile LAS unsigned* st) {
    XcdBarrier b; b.bar = bar; b.x = xb_xcc_id(); b.st = st;
    if (threadIdx.x == 0) (void)xb_add(&bar[XB_XCNT(b.x)], 1u);
    return b;
}
__device__ __forceinline__ void xcd_barrier_complete(unsigned* bar, unsigned x, unsigned& nloc, unsigned& nx) {
    const unsigned G = gridDim.x * gridDim.y * gridDim.z;
    unsigned sum, cnt, mine, sp = 0u;
    for (;;) {
        sum = 0u; cnt = 0u; mine = 0u;
#pragma unroll
        for (unsigned j = 0; j < 16; ++j) { const unsigned c = xb_ld(&bar[XB_XCNT(j)]); sum += c; cnt += (c > 0u) ? 1u : 0u; mine = (j == x) ? c : mine; }
        if (sum == G) break;
        __builtin_amdgcn_s_sleep(1);
        if ((++sp & 255u) == 0u) { if (xb_ld(&bar[XB_TMO])) break; if (sp > XB_SPIN_CAP) { atomicAdd(&bar[XB_TMO], 1u); break; } }
    }
    nloc = mine > 0u ? mine : 1u; nx = cnt > 0u ? cnt : 1u;
}
__device__ __forceinline__ void xcd_barrier(const XcdBarrier& b) {
    asm volatile("s_waitcnt vmcnt(0)" ::: "memory");
    __syncthreads();
    if (threadIdx.x == 0) {
        unsigned* bar = b.bar;
        __builtin_amdgcn_s_waitcnt(0);
        unsigned nloc = b.st[0], nx = b.st[1];
        if (nloc == 0u) { xcd_barrier_complete(bar, b.x, nloc, nx); b.st[0] = nloc; b.st[1] = nx; }
        const unsigned old = xb_add(&bar[XB_XSUB(b.x)], 1u);
        const unsigned gen = old / nloc;
        if (old + 1u == (gen + 1u) * nloc) {
            __builtin_amdgcn_fence(__ATOMIC_RELEASE, "agent");
            asm volatile("s_waitcnt vmcnt(0)" ::: "memory");
            const unsigned og = xb_add(&bar[XB_TOP], 1u);
            const unsigned tg = og / nx;
            if (og + 1u == (tg + 1u) * nx) xb_add(&bar[XB_TOPGEN], 1u);
            else XB_SPIN(xb_ld(&bar[XB_TOPGEN]) == tg, bar);
            __builtin_amdgcn_fence(__ATOMIC_ACQUIRE, "agent");
            xb_add(&bar[XB_XGEN(b.x)], 1u);
            asm volatile("s_waitcnt vmcnt(0)" ::: "memory");
        } else {
            XB_SPIN(xb_ld(&bar[XB_XGEN(b.x)]) == gen, bar);
            __builtin_amdgcn_fence(__ATOMIC_ACQUIRE, "agent");
            asm volatile("s_waitcnt vmcnt(0)" ::: "memory");
        }
    }
    __syncthreads();
}

struct Args { const float* in[27]; float* out; unsigned char* ws; int ph_lo, ph_hi; };
struct Frame { LAS unsigned char* lds; volatile LAS unsigned* MISC; gu32* ctl; int tid, lane, wave, vcu, G; };
__device__ __forceinline__ float wave_sum(float v) {
#pragma unroll
    for (int o = 1; o < 64; o <<= 1) v += __shfl_xor(v, o);
    return v;
}

__device__ __forceinline__ void transpose_item64(const float* W, int K, int N, bf16* WT, int k0, int n0, int drow0, LAS bf16* T, int lane) {
    const int r4 = lane >> 4, cg = lane & 15;
    f32x4 v[16];
    const float* wp = W + (size_t)(k0 + 8 * r4) * N + n0 + 4 * cg;
#pragma unroll
    for (int i = 0; i < 16; ++i) v[i] = *(const GAS f32x4*)(wp + (size_t)(32 * (i >> 3) + (i & 7)) * N);
#pragma unroll
    for (int q = 0; q < 2; ++q)
#pragma unroll
        for (int j = 0; j < 4; ++j) {
            u32x4 w; w.x = gg::cvt_pk_bf16(v[8 * q + 0][j], v[8 * q + 1][j]); w.y = gg::cvt_pk_bf16(v[8 * q + 2][j], v[8 * q + 3][j]);
            w.z = gg::cvt_pk_bf16(v[8 * q + 4][j], v[8 * q + 5][j]); w.w = gg::cvt_pk_bf16(v[8 * q + 6][j], v[8 * q + 7][j]);
            *(LAS u32x4*)(T + (4 * cg + j) * 72 + 32 * q + 8 * r4) = w;
        }
    LDS_WAIT(); asm volatile("" ::: "memory");
    const int kc = lane & 7, nl = lane >> 3;
#pragma unroll
    for (int ps = 0; ps < 8; ++ps) { const int n = 8 * ps + nl; const u32x4 w = *(const LAS u32x4*)(T + n * 72 + 8 * kc);
        *(GAS u32x4*)(WT + (size_t)(drow0 + n) * K + k0 + 8 * kc) = w; }
    LDS_WAIT(); asm volatile("" ::: "memory");
}
template <bool ILV>
__device__ __forceinline__ void transpose_matrix(const Frame& F, const float* W, int K, int N, bf16* WT, int ilv_half, int& item_base, int gw, int NGW) {
    LAS bf16* T = (LAS bf16*)(F.lds + RING_OFF + F.wave * 16384);
    const int nblk = N / 64, nitems = (K / 64) * nblk;
    const int first = (gw - (item_base % NGW) + NGW) % NGW;
    for (int it = first; it < nitems; it += NGW) {
        const int kb = it / nblk, nb = it % nblk, k0 = 64 * kb, n0 = 64 * nb;
        const int drow0 = ILV ? (256 * (n0 >> 7) + 128 * ilv_half + (n0 & 127)) : n0;
        transpose_item64(W, K, N, WT, k0, n0, drow0, T, F.lane);
    }
    item_base += nitems;
}

__device__ __forceinline__ void ada_phase(const Frame& F, const float* c, const float* cctx, const float* ada_w, const float* ada_b, float* mod) {
    LAS float* sv = (LAS float*)(F.lds + RING_OFF);
    LAS float* red = (LAS float*)(F.lds + RING_OFF + 49152);
    for (int i = F.tid; i < 3 * DM; i += NWAVES * 64) { const int v = i / DM, k = i % DM; const float x = v < 2 ? c[v * DM + k] : cctx[k]; sv[i] = silu_f(x); }
    __syncthreads();
    const int NCOL = 6 * DM;
    for (int blk = F.vcu; blk < NCOL / 96; blk += F.G) {
        const int n0 = blk * 96;
        const int cg = F.tid % 24, rs = F.tid / 24;
        f32x4 a0 = {0.f, 0.f, 0.f, 0.f}, a1 = a0, a2 = a0;
        if (rs < 21) {
            const float* wp = ada_w + n0 + 4 * cg;
#pragma unroll 8
            for (int k = rs; k < DM; k += 21) {
                const f32x4 w = *(const f32x4*)(wp + (size_t)k * NCOL);
                a0 += w * sv[k]; a1 += w * sv[DM + k]; a2 += w * sv[2 * DM + k];
            }
            LAS float* r = red + (rs * 3) * 96 + 4 * cg;
            *(LAS f32x4*)(r) = a0; *(LAS f32x4*)(r + 96) = a1; *(LAS f32x4*)(r + 192) = a2;
        }
        __syncthreads();
        if (F.tid < 288) {
            const int v = F.tid / 96, n = F.tid % 96; float s = 0.f;
            for (int r = 0; r < 21; ++r) s += red[(r * 3 + v) * 96 + n];
            mod[(size_t)v * NCOL + n0 + n] = s + ada_b[n0 + n];
        }
        __syncthreads();
    }
}

__device__ __forceinline__ void norm_mod_row(const float* xrow, const float* g, const float* sh, const float* sc, bf16* orow, int lane, bf16* xcopy = nullptr) {
    const GAS f32x4* xr = (const GAS f32x4*)xrow + lane;
    f32x4 v[16]; float s = 0.f;
#pragma unroll
    for (int j = 0; j < 16; ++j) { v[j] = xr[64 * j]; s += (v[j].x * v[j].x + v[j].y * v[j].y) + (v[j].z * v[j].z + v[j].w * v[j].w); }
    if (xcopy) { GAS u32x2* c8 = (GAS u32x2*)xcopy + lane;
#pragma unroll
        for (int j = 0; j < 16; ++j) { u32x2 w; w.x = gg::cvt_pk_bf16(v[j].x, v[j].y); w.y = gg::cvt_pk_bf16(v[j].z, v[j].w); c8[64 * j] = w; } }
    const float rstd = 1.f / sqrtf(wave_sum(s) * (1.f / DM) + EPS);
    GAS u32x2* o8 = (GAS u32x2*)orow + lane;
#pragma unroll
    for (int j = 0; j < 16; ++j) {
        const int col = 4 * (lane + 64 * j);
        const f32x4 gg_ = *(const f32x4*)(g + col), shv = *(const f32x4*)(sh + col), scv = *(const f32x4*)(sc + col);
        const f32x4 y = (v[j] * rstd) * gg_ * (scv + 1.f) + shv;
        u32x2 w; w.x = pk2(y.x, y.y); w.y = pk2(y.z, y.w); o8[64 * j] = w;
    }
}
__device__ __forceinline__ void norm_mod_row_b(const bf16* xrow, const float* g, const float* sh, const float* sc, bf16* orow, int lane) {
    const GAS u32x4* xr = (const GAS u32x4*)xrow + lane;
    f32x4 v[8][2]; float s = 0.f;
#pragma unroll
    for (int j = 0; j < 8; ++j) { const u32x4 w = xr[64 * j]; v[j][0] = bf4lo(w); v[j][1] = bf4hi(w);
#pragma unroll
        for (int t = 0; t < 2; ++t) s += (v[j][t].x * v[j][t].x + v[j][t].y * v[j][t].y) + (v[j][t].z * v[j][t].z + v[j][t].w * v[j][t].w); }
    const float rstd = 1.f / sqrtf(wave_sum(s) * (1.f / DM) + EPS);
    GAS u32x4* o = (GAS u32x4*)orow + lane;
#pragma unroll
    for (int j = 0; j < 8; ++j) { const int col = 8 * (lane + 64 * j); f32x4 y[2];
#pragma unroll
        for (int t = 0; t < 2; ++t) { const f32x4 gg_ = *(const f32x4*)(g + col + 4 * t), shv = *(const f32x4*)(sh + col + 4 * t), scv = *(const f32x4*)(sc + col + 4 * t); y[t] = (v[j][t] * rstd) * gg_ * (scv + 1.f) + shv; }
        o[64 * j] = gg::pack8(y[0], y[1]); }
}
__device__ __forceinline__ void stage_mod_lds(const Frame& F, LAS float* P, const float* g, const float* sh, const float* sc, int set) {
    for (int i = F.tid * 4; i < DM; i += NWAVES * 64 * 4) {
        const f32x4 gv = *(const f32x4*)(g + i), sv = *(const f32x4*)(sc + i), hv = *(const f32x4*)(sh + i);
        *(LAS f32x4*)(P + set * 2 * DM + i) = gv * (sv + 1.f); *(LAS f32x4*)(P + set * 2 * DM + DM + i) = hv; }
}
__device__ __forceinline__ u32x4 pair_merge(const u32x2 aj, const u32x2 aj1, bool even) {
    const u32x2 snd = even ? aj1 : aj; u32x2 rcv;
    rcv.x = (unsigned)__builtin_amdgcn_update_dpp(0, (int)snd.x, 0xB1, 0xf, 0xf, false); rcv.y = (unsigned)__builtin_amdgcn_update_dpp(0, (int)snd.y, 0xB1, 0xf, 0xf, false);
    u32x4 o; if (even) { o.x = aj.x; o.y = aj.y; o.z = rcv.x; o.w = rcv.y; } else { o.x = rcv.x; o.y = rcv.y; o.z = aj1.x; o.w = aj1.y; } return o;
}
__device__ __forceinline__ void norm_mod_row_lds(const float* xrow, const LAS float* gm, const LAS float* shl, bf16* orow, int lane, bf16* xcopy) {
    const GAS f32x4* xr = (const GAS f32x4*)xrow + lane;
    f32x4 v[16]; float s = 0.f;
#pragma unroll
    for (int j = 0; j < 16; ++j) { v[j] = xr[64 * j]; s += (v[j].x * v[j].x + v[j].y * v[j].y) + (v[j].z * v[j].z + v[j].w * v[j].w); }
    const bool even = (lane & 1) == 0;
    const int ocol = even ? 4 * lane : 4 * (lane - 1) + 256;
    if (xcopy) {
#pragma unroll
        for (int j = 0; j < 16; j += 2) { u32x2 a, b; a.x = gg::cvt_pk_bf16(v[j].x, v[j].y); a.y = gg::cvt_pk_bf16(v[j].z, v[j].w); b.x = gg::cvt_pk_bf16(v[j + 1].x, v[j + 1].y); b.y = gg::cvt_pk_bf16(v[j + 1].z, v[j + 1].w);
            *(GAS u32x4*)(xcopy + ocol + 256 * j) = pair_merge(a, b, even); } }
    const float rstd = 1.f / sqrtf(wave_sum(s) * (1.f / DM) + EPS);
#pragma unroll
    for (int j = 0; j < 16; j += 2) { u32x2 a, b;
        { const int col = 4 * (lane + 64 * j); const f32x4 y = (v[j] * rstd) * *(const LAS f32x4*)(gm + col) + *(const LAS f32x4*)(shl + col); a.x = gg::cvt_pk_bf16(y.x, y.y); a.y = gg::cvt_pk_bf16(y.z, y.w); }
        { const int col = 4 * (lane + 64 * (j + 1)); const f32x4 y = (v[j + 1] * rstd) * *(const LAS f32x4*)(gm + col) + *(const LAS f32x4*)(shl + col); b.x = gg::cvt_pk_bf16(y.x, y.y); b.y = gg::cvt_pk_bf16(y.z, y.w); }
        *(GAS u32x4*)(orow + ocol + 256 * j) = pair_merge(a, b, even); }
}
__device__ __forceinline__ void norm_mod_row_b_lds(const bf16* xrow, const LAS float* gm, const LAS float* shl, bf16* orow, int lane) {
    const GAS u32x4* xr = (const GAS u32x4*)xrow + lane;
    u32x4 w[8]; float s = 0.f;
#pragma unroll
    for (int j = 0; j < 8; ++j) { w[j] = xr[64 * j]; const f32x4 a = bf4lo(w[j]), b = bf4hi(w[j]); s += (a.x * a.x + a.y * a.y) + (a.z * a.z + a.w * a.w) + (b.x * b.x + b.y * b.y) + (b.z * b.z + b.w * b.w); }
    const float rstd = 1.f / sqrtf(wave_sum(s) * (1.f / DM) + EPS);
    GAS u32x4* o = (GAS u32x4*)orow + lane;
#pragma unroll
    for (int j = 0; j < 8; ++j) { const int col = 8 * (lane + 64 * j);
        const f32x4 y0 = (bf4lo(w[j]) * rstd) * *(const LAS f32x4*)(gm + col) + *(const LAS f32x4*)(shl + col), y1 = (bf4hi(w[j]) * rstd) * *(const LAS f32x4*)(gm + col + 4) + *(const LAS f32x4*)(shl + col + 4);
        o[64 * j] = gg::pack8(y0, y1); }
}
__device__ __forceinline__ void norm_row_b2f_lds(const bf16* xrow, const LAS float* gl, float* orow, int lane) {
    const GAS u32x2* xr = (const GAS u32x2*)xrow + lane;
    u32x2 w[16]; float s = 0.f;
#pragma unroll
    for (int j = 0; j < 16; ++j) { w[j] = xr[64 * j]; const float a0 = __builtin_bit_cast(float, w[j].x << 16), a1 = __builtin_bit_cast(float, w[j].x & 0xffff0000u), a2 = __builtin_bit_cast(float, w[j].y << 16), a3 = __builtin_bit_cast(float, w[j].y & 0xffff0000u);
        s += (a0 * a0 + a1 * a1) + (a2 * a2 + a3 * a3); }
    const float rstd = 1.f / sqrtf(wave_sum(s) * (1.f / DM) + EPS);
#pragma unroll
    for (int j = 0; j < 16; ++j) { const int col = 4 * lane + 256 * j;
        f32x4 v; v.x = __builtin_bit_cast(float, w[j].x << 16); v.y = __builtin_bit_cast(float, w[j].x & 0xffff0000u); v.z = __builtin_bit_cast(float, w[j].y << 16); v.w = __builtin_bit_cast(float, w[j].y & 0xffff0000u);
        *(GAS f32x4*)(orow + col) = (v * rstd) * *(const LAS f32x4*)(gl + col); }
}
__device__ __forceinline__ void norm_row_b2f(const bf16* xrow, const float* g, float* orow, int lane) {
    const GAS u32x4* xr = (const GAS u32x4*)xrow + lane;
    f32x4 v[8][2]; float s = 0.f;
#pragma unroll
    for (int j = 0; j < 8; ++j) { const u32x4 w = xr[64 * j]; v[j][0] = bf4lo(w); v[j][1] = bf4hi(w);
#pragma unroll
        for (int t = 0; t < 2; ++t) s += (v[j][t].x * v[j][t].x + v[j][t].y * v[j][t].y) + (v[j][t].z * v[j][t].z + v[j][t].w * v[j][t].w); }
    const float rstd = 1.f / sqrtf(wave_sum(s) * (1.f / DM) + EPS);
#pragma unroll
    for (int j = 0; j < 8; ++j) { const int col = 8 * (lane + 64 * j);
#pragma unroll
        for (int t = 0; t < 2; ++t) *(GAS f32x4*)(orow + col + 4 * t) = (v[j][t] * rstd) * *(const f32x4*)(g + col + 4 * t); }
}
__device__ __forceinline__ void norm_row_f32(const float* xrow, const float* g, float* orow, int lane) {
    const GAS f32x4* xr = (const GAS f32x4*)xrow + lane;
    f32x4 v[16]; float s = 0.f;
#pragma unroll
    for (int j = 0; j < 16; ++j) { v[j] = xr[64 * j]; s += (v[j].x * v[j].x + v[j].y * v[j].y) + (v[j].z * v[j].z + v[j].w * v[j].w); }
    const float rstd = 1.f / sqrtf(wave_sum(s) * (1.f / DM) + EPS);
    GAS f32x4* o = (GAS f32x4*)orow + lane;
#pragma unroll
    for (int j = 0; j < 16; ++j) { const int col = 4 * (lane + 64 * j); o[64 * j] = (v[j] * rstd) * *(const f32x4*)(g + col); }
}

__device__ __forceinline__ void dft_tables(const Frame& F, bf16* F1, bf16* F2, float* TW) {
    const int gt = F.vcu * (NWAVES * 64) + F.tid, NT = F.G * NWAVES * 64;
    for (int i = gt; i < 256 * 256; i += NT) {
        const int row = i >> 8, col = i & 255, rp = row >> 7, k1 = row & 127, ri = col >> 7, ls = col & 127;
        float s, c; sincos_rev((float)((k1 * ls) & 127) * (1.f / 128.f), s, c);
        const float v = (rp == ri) ? c : (rp == 0 ? s : -s);
        F1[i] = (bf16)f2bf(v);
    }
    for (int i = gt; i < 256 * 512; i += NT) {
        const int row = i >> 9, col = i & 511, j = row >> 6, k2 = row & 63, jp = col >> 7, ri = (col >> 6) & 1, lf = col & 63;
        float s, c; sincos_rev((float)((k2 * lf) & 63) * (1.f / 64.f), s, c);
        F2[i] = (bf16)f2bf(j == jp ? (ri == 0 ? c : s) : 0.f);
    }
    for (int i = gt; i < 8192; i += NT) { float s, c; sincos_rev((float)i * (1.f / 8192.f), s, c); TW[2 * i] = c; TW[2 * i + 1] = -s; }
}
__device__ __forceinline__ void wcs_phase(const Frame& F, const float* fw, bf16* Wcs) {
    LAS float* cs = (LAS float*)(F.lds + RING_OFF);
    LAS float* Wl = (LAS float*)(F.lds + RING_OFF + 4096);
    for (int i = F.tid; i < 512; i += NWAVES * 64) { float s, c; sincos_rev((float)i * (1.f / 512.f), s, c); cs[2 * i] = c; cs[2 * i + 1] = s; }
    __syncthreads();
    for (int it0 = F.vcu * NWAVES; it0 < FH * 8 * 64; it0 += F.G * NWAVES) {
        const int it = it0 + F.wave, h = it >> 9, db = (it >> 6) & 7, d = db * 64 + F.lane, ew0 = (it0 & 63) * 8;
        f32x2 acc[8];
#pragma unroll
        for (int j = 0; j < 8; ++j) acc[j] = (f32x2){0.f, 0.f};
        for (int mh = 0; mh < 2; ++mh) {
            __syncthreads();
            { const float* src = fw + (size_t)h * FHD * FHD + (size_t)(mh * 256) * FHD + ew0;
#pragma unroll
              for (int p = 0; p < 8; ++p) { const int idx = F.tid + p * 512, r = idx >> 4, c4 = (idx & 15) * 4; *(LAS f32x4*)(Wl + r * 64 + c4) = *(const f32x4*)(src + (size_t)r * FHD + c4); } }
            __syncthreads();
            const LAS float* wl = Wl + F.wave * 8;
#pragma unroll 4
            for (int mm = 0; mm < 256; ++mm) {
                const int m = mh * 256 + mm, idx = (m * d) & 511; const f32x2 c2 = *(const LAS f32x2*)(cs + 2 * idx);
                const f32x4 w0 = *(const LAS f32x4*)(wl + mm * 64), w1 = *(const LAS f32x4*)(wl + mm * 64 + 4);
                acc[0] += c2 * (f32x2){w0.x, w0.x}; acc[1] += c2 * (f32x2){w0.y, w0.y}; acc[2] += c2 * (f32x2){w0.z, w0.z}; acc[3] += c2 * (f32x2){w0.w, w0.w};
                acc[4] += c2 * (f32x2){w1.x, w1.x}; acc[5] += c2 * (f32x2){w1.y, w1.y}; acc[6] += c2 * (f32x2){w1.z, w1.z}; acc[7] += c2 * (f32x2){w1.w, w1.w};
            }
        }
        const int e0 = (it & 63) * 8;
        bf16* o = Wcs + (size_t)h * 1024 * FHD + d;
#pragma unroll
        for (int j = 0; j < 8; ++j) { o[(size_t)(e0 + j) * FHD] = (bf16)f2bf(acc[j].x * (1.f / 2048.f)); o[(size_t)(512 + e0 + j) * FHD] = (bf16)f2bf(-acc[j].y * (1.f / 2048.f)); }
    }
    __syncthreads();
}
__device__ __forceinline__ void s5_matrices(const Frame& F, const float* const* in, bf16* SBm, bf16* KCm);

enum { IN_X = 0, IN_C, IN_CTX, IN_CCTX, IN_ADAW, IN_ADAB, IN_N1G, IN_N2G, IN_WIN, IN_WOUT, IN_FW, IN_LRE, IN_LIM, IN_LDT, IN_BRE, IN_BIM, IN_CRE, IN_CIM, IN_SD,
       IN_GWA, IN_GBA, IN_GWB, IN_GBB, IN_WG, IN_WU, IN_WD, IN_FG };

template <class P2, class PF> struct S5TabT { P2 LP, Bb, Cc; PF Kt, dsk; };
template <class P2> HD cpx ldc(P2 p, int i) { const f32x2 v = p[i]; return cpx{v.x, v.y}; }
template <class TT> HD float sb_entry(const TT& T, int row, int col) {
    const int dir = row >> 7, p = (row >> 1) & 63, ri = row & 1, j = col >> 4, hi = col & 15, e = dir == 0 ? 15 - j : j;
    const cpx t = cmul(ldc(T.LP, (dir * 17 + e) * 64 + p), ldc(T.Bb, (dir * 64 + p) * 16 + hi)); return ri == 0 ? t.r : t.i;
}
template <class TT> HD float kc_entry(const TT& T, int row, int col) {
    const int jo = row >> 4, ho = row & 15;
    if (col < 256) { const int i = col >> 4, hi = col & 15;
        if (i < jo) return T.Kt[((0 * 16 + (jo - i)) * 16 + ho) * 16 + hi];
        if (i > jo) return T.Kt[((1 * 16 + (i - jo)) * 16 + ho) * 16 + hi];
        return T.Kt[((0 * 16 + 0) * 16 + ho) * 16 + hi] + T.Kt[((1 * 16 + 0) * 16 + ho) * 16 + hi] + (ho == hi ? T.dsk[ho] : 0.f); }
    const int cc = col - 256, dir = cc >> 7, p = (cc >> 1) & 63, ri = cc & 1, e = dir == 0 ? jo + 1 : 16 - jo;
    const cpx t = cmul(ldc(T.Cc, (dir * 16 + ho) * 64 + p), ldc(T.LP, (dir * 17 + e) * 64 + p)); return ri == 0 ? t.r : -t.i;
}

__device__ __forceinline__ void s5_matrices(const Frame& F, const float* const* in, bf16* SBm, bf16* KCm) {
    LAS f32x2* LP = (LAS f32x2*)(F.lds + RING_OFF);
    LAS f32x2* Bb = (LAS f32x2*)(F.lds + RING_OFF + 17408);
    LAS f32x2* Cc = (LAS f32x2*)(F.lds + RING_OFF + 33792);
    LAS float* Kt = (LAS float*)(F.lds + RING_OFF + 50176);
    LAS float* dsk = (LAS float*)(F.lds + RING_OFF + 82944);
    for (int it = F.vcu; it < SG * 2; it += F.G) {
        const int g = it >> 1, half = it & 1;
        __syncthreads();
        if (F.tid < 128) { const int dir = F.tid >> 6, p = F.tid & 63; const S5P q = s5_param(in[IN_LRE], in[IN_LIM], in[IN_LDT], dir, g, p);
            for (int n = 0; n <= 16; ++n) { const cpx v = s5_pow(q, (float)n); LP[(dir * 17 + n) * 64 + p] = (f32x2){v.r, v.i}; } }
        if (F.tid >= 128 && F.tid < 144) dsk[F.tid - 128] = in[IN_SD][g * 16 + (F.tid - 128)];
        for (int i = F.tid; i < 2 * 64 * 16; i += NWAVES * 64) { const int dir = i >> 10, p = (i >> 4) & 63, h = i & 15;
            const S5P q = s5_param(in[IN_LRE], in[IN_LIM], in[IN_LDT], dir, g, p); const cpx cf = s5_coef(q);
            const size_t bi = (((size_t)dir * SG + g) * SP + p) * SH + h; const cpx v = cmul(cf, cpx{in[IN_BRE][bi], in[IN_BIM][bi]}); Bb[i] = (f32x2){v.r, v.i};
            const int ho = (i >> 6) & 15, pp = i & 63; const size_t ci = (((size_t)dir * SG + g) * SH + ho) * SP + pp; Cc[i] = (f32x2){in[IN_CRE][ci], in[IN_CIM][ci]}; }
        __syncthreads();
        {
            const int dir = F.tid >> 8, tau = (F.tid >> 4) & 15, ho = F.tid & 15; float a[16];
#pragma unroll
            for (int h = 0; h < 16; ++h) a[h] = 0.f;
            for (int p = 0; p < 64; ++p) { const f32x2 c = Cc[(dir * 16 + ho) * 64 + p], l = LP[(dir * 17 + tau) * 64 + p]; const cpx t = cpx{c.x * l.x - c.y * l.y, c.x * l.y + c.y * l.x};
#pragma unroll
                for (int h = 0; h < 16; ++h) { const f32x2 b = Bb[(dir * 64 + p) * 16 + h]; a[h] += t.r * b.x - t.i * b.y; } }
#pragma unroll
            for (int h = 0; h < 16; ++h) Kt[((dir * 16 + tau) * 16 + ho) * 16 + h] = a[h];
        }
        __syncthreads();
        const S5TabT<const LAS f32x2*, const LAS float*> T{LP, Bb, Cc, Kt, dsk};
        bf16* sb = SBm + (size_t)g * 256 * 256 + (size_t)half * 128 * 256; bf16* kc = KCm + (size_t)g * 256 * 512 + (size_t)half * 128 * 512;
        for (int ck = F.tid; ck < 128 * 256 / 8; ck += NWAVES * 64) { const int row = half * 128 + (ck >> 5), c0 = (ck & 31) * 8; u32x4 w;
            w.x = pk2(sb_entry(T, row, c0), sb_entry(T, row, c0 + 1)); w.y = pk2(sb_entry(T, row, c0 + 2), sb_entry(T, row, c0 + 3));
            w.z = pk2(sb_entry(T, row, c0 + 4), sb_entry(T, row, c0 + 5)); w.w = pk2(sb_entry(T, row, c0 + 6), sb_entry(T, row, c0 + 7));
            *(u32x4*)(sb + (size_t)(ck >> 5) * 256 + c0) = w; }
        for (int ck = F.tid; ck < 128 * 512 / 8; ck += NWAVES * 64) { const int row = half * 128 + (ck >> 6), c0 = (ck & 63) * 8; u32x4 w;
            w.x = pk2(kc_entry(T, row, c0), kc_entry(T, row, c0 + 1)); w.y = pk2(kc_entry(T, row, c0 + 2), kc_entry(T, row, c0 + 3));
            w.z = pk2(kc_entry(T, row, c0 + 4), kc_entry(T, row, c0 + 5)); w.w = pk2(kc_entry(T, row, c0 + 6), kc_entry(T, row, c0 + 7));
            *(u32x4*)(kc + (size_t)(ck >> 6) * 512 + c0) = w; }
    }
    __syncthreads();
}

__device__ __forceinline__ void ctx_gemm(const Frame& F, const bf16* HnCtx, const bf16* WinS5, float* Zc) {
    LAS float* part = (LAS float*)(F.lds + RING_OFF);
    const int fr = F.lane & 15, fq = F.lane >> 4;
    for (int t = F.vcu; t < (MCTX / 64) * (2048 / 64); t += F.G) {
        const int mt = t >> 5, ntile = t & 31;
        f32x4 acc[4][4];
#pragma unroll
        for (int a = 0; a < 4; ++a)
#pragma unroll
            for (int b = 0; b < 4; ++b) acc[a][b] = (f32x4){0.f, 0.f, 0.f, 0.f};
        const bf16* ap = HnCtx + (size_t)(mt * 64 + fr) * DM + F.wave * 64 + fq * 16;
        const bf16* bp = WinS5 + (size_t)(ntile * 64 + fr) * DM + F.wave * 64 + fq * 16;
#define CTX_LD(af_, bf_, k_) do { _Pragma("unroll") for (int kk = 0; kk < 2; ++kk) _Pragma("unroll") for (int a = 0; a < 4; ++a) { \
            af_[kk][a] = *(const bf16x8*)(ap + (size_t)a * 16 * DM + ((k_) >> 1) * 512 + kk * 8); bf_[kk][a] = *(const bf16x8*)(bp + (size_t)a * 16 * DM + ((k_) >> 1) * 512 + kk * 8); } } while (0)
#define CTX_MM(af_, bf_) do { _Pragma("unroll") for (int kk = 0; kk < 2; ++kk) _Pragma("unroll") for (int a = 0; a < 4; ++a) _Pragma("unroll") for (int b = 0; b < 4; ++b) \
            acc[a][b] = __builtin_amdgcn_mfma_f32_16x16x32_bf16(bf_[kk][b], af_[kk][a], acc[a][b], 0, 0, 0); } while (0)
        {
            bf16x8 af0[2][4], bf0[2][4], af1[2][4], bf1[2][4];
            CTX_LD(af0, bf0, 0);
#pragma unroll
            for (int k = 0; k < 16; k += 4) {
                CTX_LD(af1, bf1, k + 2);
                CTX_MM(af0, bf0);
                if (k + 4 < 16) CTX_LD(af0, bf0, k + 4);
                CTX_MM(af1, bf1);
            }
        }
#undef CTX_LD
#undef CTX_MM
        __syncthreads();
#pragma unroll
        for (int a = 0; a < 4; ++a)
#pragma unroll
            for (int b = 0; b < 4; ++b) *(LAS f32x4*)(part + ((size_t)F.wave * 64 + a * 16 + fr) * 64 + ((b * 16 + 4 * fq) ^ (fr * 4))) = acc[a][b];
        __syncthreads();
        for (int i = F.tid; i < 64 * 64 / 4; i += NWAVES * 64) { const int r = i >> 4, c4 = (i & 15) * 4, sw = r * 64 + (c4 ^ ((r & 15) * 4));
            f32x4 s = *(LAS f32x4*)(part + sw);
#pragma unroll
            for (int w = 1; w < 8; ++w) s += *(LAS f32x4*)(part + (size_t)w * 4096 + sw); *(f32x4*)(Zc + (size_t)(mt * 64 + r) * 2048 + ntile * 64 + c4) = s; }
        __syncthreads();
    }
}

__device__ __forceinline__ void carry_phase(const Frame& F, const float* const* in, const float* Zc, const bf16* Sst, bf16* UH, const bf16* SBm) {
    LAS float* uc = (LAS float*)(F.lds + RING_OFF);
    LAS bf16* Sbuf = (LAS bf16*)(F.lds + RING_OFF + 32768);
    LAS bf16* Hbuf = (LAS bf16*)(F.lds + RING_OFF + 65536);
    LAS float* Scx = (LAS float*)(F.lds + RING_OFF + 65536);
    for (int bg = F.vcu; bg < NB * SG; bg += F.G) {
        const int b = bg / SG, g = bg % SG;
        __syncthreads();
        const int fr = F.lane & 15, fq = F.lane >> 4;
        bf16x8 sbf[2][8];
        { const bf16* sp = SBm + (size_t)g * 65536 + (size_t)(F.wave * 32 + fr) * 256 + fq * 8;
#pragma unroll
          for (int nb = 0; nb < 2; ++nb)
#pragma unroll
              for (int s = 0; s < 8; ++s) sbf[nb][s] = *(const bf16x8*)(sp + nb * 16 * 256 + s * 32); }
        { const int s = F.tid >> 1, hf = F.tid & 1; const float* zp = Zc + (size_t)(b * CTXL + s) * 2048 + g * 16 + hf * 8; LAS float* up = uc + (s >> 4) * 260 + (s & 15) * 16 + hf * 8;
          *(LAS f32x4*)up = *(const f32x4*)zp; *(LAS f32x4*)(up + 4) = *(const f32x4*)(zp + 4); }
        __syncthreads();
        {
            f32x4 acc[2] = {(f32x4){0.f, 0.f, 0.f, 0.f}, (f32x4){0.f, 0.f, 0.f, 0.f}};
#pragma unroll
            for (int s = 0; s < 8; ++s) {
                const f32x4 u0 = *(LAS f32x4*)(uc + fr * 260 + s * 32 + fq * 8), u1 = *(LAS f32x4*)(uc + fr * 260 + s * 32 + fq * 8 + 4);
                const bf16x8 af = __builtin_bit_cast(bf16x8, gg::pack8(u0, u1));
#pragma unroll
                for (int nb = 0; nb < 2; ++nb) acc[nb] = __builtin_amdgcn_mfma_f32_16x16x32_bf16(sbf[nb][s], af, acc[nb], 0, 0, 0);
            }
#pragma unroll
            for (int nb = 0; nb < 2; ++nb) *(LAS f32x4*)(Scx + fr * 260 + F.wave * 32 + nb * 16 + 4 * fq) = acc[nb];
        }
        __syncthreads();
        const int dir = F.wave & 1, seg = F.wave >> 1, p = F.lane;
        const S5P q = s5_param(in[IN_LRE], in[IN_LIM], in[IN_LDT], dir, g, p);
        cpx H{0.f, 0.f}; const cpx l16 = s5_pow(q, 16.f);
        if (seg == 0) {
#pragma unroll
            for (int cc = 0; cc < 16; ++cc) { const int c = dir == 0 ? cc : 15 - cc; const f32x2 sv = *(LAS f32x2*)(Scx + c * 260 + dir * 128 + 2 * p);
                H = cpx{__builtin_fmaf(l16.r, H.r, __builtin_fmaf(-l16.i, H.i, sv.x)), __builtin_fmaf(l16.r, H.i, __builtin_fmaf(l16.i, H.r, sv.y))}; }
        }
        const bf16* sbase = Sst + ((size_t)g * 1024 + (size_t)b * NCH) * 256;
        bf16* hbase = UH + ((size_t)g * 1024 + (size_t)b * NCH) * 512 + 256;
#define CARRY_SRC(pc_, i_) (sbase + (size_t)((((F.tid + (i_) * 512) >> 10) == 0) ? 64 * (pc_) + (((F.tid + (i_) * 512) >> 4) & 63) : NCH - 1 - 64 * (pc_) - (((F.tid + (i_) * 512) >> 4) & 63)) * 256 + ((F.tid + (i_) * 512) >> 10) * 128 + ((F.tid + (i_) * 512) & 15) * 8)
        u32x4 pre[4];
#pragma unroll
        for (int i = 0; i < 4; ++i) pre[i] = *(const u32x4*)CARRY_SRC(0, i);
        for (int pc = 0; pc < 8; ++pc) {
#pragma unroll
            for (int i = 0; i < 4; ++i) { const int id = F.tid + i * 512, d = id >> 10, ci = (id >> 4) & 63, part = id & 15; *(LAS u32x4*)(Sbuf + (d * 64 + ci) * 128 + part * 8) = pre[i]; }
            if (pc + 1 < 8) {
#pragma unroll
                for (int i = 0; i < 4; ++i) pre[i] = *(const u32x4*)CARRY_SRC(pc + 1, i);
            }
            __syncthreads();
            if (seg == 0) {
                LAS unsigned* Sw = (LAS unsigned*)Sbuf + dir * 64 * 64 + p; LAS unsigned* Hw = (LAS unsigned*)Hbuf + dir * 64 * 64 + p;
#pragma unroll 8
                for (int ci = 0; ci < 64; ++ci) {
                    Hw[ci * 64] = gg::cvt_pk_bf16(H.r, H.i);
                    const unsigned sv = Sw[ci * 64];
                    const float sr = __builtin_bit_cast(float, sv << 16), si = __builtin_bit_cast(float, sv & 0xffff0000u);
                    H = cpx{__builtin_fmaf(l16.r, H.r, __builtin_fmaf(-l16.i, H.i, sr)), __builtin_fmaf(l16.r, H.i, __builtin_fmaf(l16.i, H.r, si))};
                }
            }
            __syncthreads();
#pragma unroll
            for (int i = 0; i < 4; ++i) { const int id = F.tid + i * 512, d = id >> 10, ci = (id >> 4) & 63, part = id & 15;
                const int chn = d == 0 ? 64 * pc + ci : NCH - 1 - 64 * pc - ci;
                *(u32x4*)(hbase + (size_t)chn * 512 + d * 128 + part * 8) = *(LAS u32x4*)(Hbuf + (d * 64 + ci) * 128 + part * 8); }
        }
#undef CARRY_SRC
    }
    __syncthreads();
}

constexpr int NPHASE = 12;
#ifndef MK_FOURIER
#define MK_FOURIER 1
#endif

__global__ void __launch_bounds__(NWAVES * 64, 2) mk_fwd(Args args) {
    extern __shared__ __attribute__((aligned(16))) unsigned char lds[];
    Frame F;
    F.lds = (LAS unsigned char*)lds;
    F.MISC = (volatile LAS unsigned*)(F.lds + MISC_OFF);
    F.tid = threadIdx.x; F.lane = F.tid & 63; F.wave = __builtin_amdgcn_readfirstlane(F.tid >> 6);
    F.G = gridDim.x; { const int bx = blockIdx.x; F.vcu = (F.G % 8 == 0) ? (bx % 8) * (F.G / 8) + bx / 8 : bx; }
    unsigned char* ws = args.ws;
    F.ctl = (gu32*)(ws + WS_CTL);
    for (int u = F.tid; u < (LDS_BYTES - LDSCTL_OFF) / 4; u += NWAVES * 64) ((LAS unsigned*)(F.lds + LDSCTL_OFF))[u] = 0u;
    __syncthreads();
    XcdBarrier bar; bar.bar = (unsigned*)(F.ctl + CW_BAR); bar.x = 0; bar.st = nullptr;
    if (!MK_PER_PHASE) bar = xcd_barrier_post((unsigned*)(F.ctl + CW_BAR), F.MISC + 8);
#define GRID_BAR() do { if (MK_PER_PHASE) { if (F.tid == 0) __hip_atomic_store(F.ctl + CW_TMO, 0xBADBA0u, RLX_AGENT); } else { xcd_barrier(bar); } } while (0)
    const int lo = args.ph_lo, hi = args.ph_hi;
#ifndef MK_PHASE_MASK
#define MK_PHASE_MASK 0xFFFF
#endif
#define IN(k) (((MK_PHASE_MASK >> (k)) & 1) && lo <= (k) && (k) < hi)
#define BOTH(k) (IN(k) && IN((k) + 1))
#ifndef MK_DUP
#define MK_DUP (-1)
#endif
#define REP(k) _Pragma("unroll") for (int rep_ = 0; rep_ < ((MK_DUP == (k)) ? 2 : 1); ++rep_)

    float* mod = (float*)(ws + WS_MOD);
    bf16* Win_t = (bf16*)(ws + WS_WIN); bf16* Wout_t = (bf16*)(ws + WS_WOUT); bf16* Wglu_t = (bf16*)(ws + WS_WGLU);
    bf16* Wgu_t = (bf16*)(ws + WS_WGU); bf16* Wdn_t = (bf16*)(ws + WS_WDN);
    bf16* Hn = (bf16*)(ws + WS_HN); bf16* Hid = (bf16*)(ws + WS_HID); bf16* CAT = (bf16*)(ws + WS_CAT); bf16* Gb = (bf16*)(ws + WS_G);
    bf16* ZF = (bf16*)(ws + WS_ZF); bf16* UH = (bf16*)(ws + WS_UH); bf16* Sst = (bf16*)(ws + WS_SST);
    float* Zc = (float*)(ws + WS_ZC); bf16* XR = (bf16*)(ws + WS_XR);
    const float* x = args.in[IN_X];
    float* out = args.out;
    const int gw = F.vcu * NWAVES + F.wave, NGW = F.G * NWAVES;

    if (IN(0)) { REP(0) {
#define P0_MEM() do { int ib = 0; \
        transpose_matrix<false>(F, args.in[IN_WIN], DM, DM, Win_t, 0, ib, gw, NGW); \
        transpose_matrix<false>(F, args.in[IN_WOUT], DM, DM, Wout_t, 0, ib, gw, NGW); \
        transpose_matrix<true>(F, args.in[IN_GWA], 2048, 2048, Wglu_t, 0, ib, gw, NGW); \
        transpose_matrix<true>(F, args.in[IN_GWB], 2048, 2048, Wglu_t, 1, ib, gw, NGW); \
        transpose_matrix<true>(F, args.in[IN_WG], DM, FFN, Wgu_t, 0, ib, gw, NGW); \
        transpose_matrix<true>(F, args.in[IN_WU], DM, FFN, Wgu_t, 1, ib, gw, NGW);         \
        __syncthreads(); \
        ada_phase(F, args.in[IN_C], args.in[IN_CCTX], args.in[IN_ADAW], args.in[IN_ADAB], mod); } while (0)
#define P0_CMP() do { dft_tables(F, (bf16*)(ws + WS_F1), (bf16*)(ws + WS_F2), (float*)(ws + WS_TW)); \
        wcs_phase(F, args.in[IN_FW], (bf16*)(ws + WS_WCS)); \
        s5_matrices(F, args.in, (bf16*)(ws + WS_SB), (bf16*)(ws + WS_KC)); } while (0)
        if (F.vcu & 1) { P0_MEM(); __syncthreads(); P0_CMP(); } else { P0_CMP(); __syncthreads(); P0_MEM(); }
#undef P0_MEM
#undef P0_CMP
        }
        if (BOTH(0)) GRID_BAR();
    }
    if (IN(1)) { REP(1) {
        { LAS float* P = (LAS float*)(F.lds + RING_OFF);
          __syncthreads();
          stage_mod_lds(F, P, args.in[IN_N1G], mod, mod + DM, 0); stage_mod_lds(F, P, args.in[IN_N1G], mod + (size_t)6 * DM, mod + (size_t)6 * DM + DM, 1);
          stage_mod_lds(F, P, args.in[IN_N1G], mod + (size_t)12 * DM, mod + (size_t)12 * DM + DM, 2);
          __syncthreads();
          for (int m = gw; m < MTOK + MCTX; m += NGW) {
              if (m < MTOK) { const int b = m / SEQ; norm_mod_row_lds(x + (size_t)m * DM, P + b * 2 * DM, P + b * 2 * DM + DM, Hn + (size_t)m * DM, F.lane, XR + (size_t)m * DM); }
              else norm_mod_row_lds(args.in[IN_CTX] + (size_t)(m - MTOK) * DM, P + 2 * 2 * DM, P + 2 * 2 * DM + DM, Hn + (size_t)m * DM, F.lane, nullptr);
          }
          __syncthreads(); }
        }
        if (BOTH(1)) GRID_BAR();
    }
    if (IN(2)) { REP(2) {
        gg::Gemm g{(const char*)Hn, (const char*)Win_t, DM * 2, DM * 2, DM / 64};
        gg::Order2D S; S.init(MTOK / 256, DM / 256, F.G, (int)blockIdx.x, g.lda, g.ldb);
        Epi1<EpiZ> E{EpiZ{ZF, UH}};
        gg::gemm_phase<Epi1<EpiZ>, gg::Order2D, true>(F.lds + RING_OFF, g, S, E);
        REP(21) ctx_gemm(F, Hn + (size_t)MTOK * DM, Win_t + (size_t)FW * DM, Zc);
        }
        if (BOTH(2)) GRID_BAR();
    }
    if (IN(3)) { {
        REP(30) { const gg::Gemm g = gemm_S(ws); gg::OrderS5 S{F.G, (int)blockIdx.x, (size_t)256 * 256 * 2}; Epi1<EpiS> E{EpiS{Sst}};
          gg::gemm_phase<Epi1<EpiS>, gg::OrderS5, true>(F.lds + RING_OFF, g, S, E); }
#if MK_FOURIER
        REP(31) { const gg::Gemm g = gemm_F1(ws); gg::OrderF1 S{F.G, (int)blockIdx.x}; Epi1<EpiF1> E{EpiF1{(bf16*)(ws + WS_X1)}};
          gg::gemm_phase<Epi1<EpiF1>, gg::OrderF1, true>(F.lds + RING_OFF, g, S, E); }
#endif
        }
        if (BOTH(3)) GRID_BAR();
    }
    if (IN(4)) { {
        REP(40) carry_phase(F, args.in, Zc, Sst, UH, (const bf16*)(ws + WS_SB));
#if MK_FOURIER
        REP(41) { const gg::Gemm g = gemm_F2(ws); gg::OrderLin S{1024, F.G, (int)blockIdx.x, (size_t)256 * 512}; EpiPairA<EpiF2> E{EpiF2{(bf16*)(ws + WS_X2), (const float*)(ws + WS_TW)}};
          gg::gemm_phase<EpiPairA<EpiF2>, gg::OrderLin, true>(F.lds + RING_OFF, g, S, E); }
#endif
        }
        if (BOTH(4)) GRID_BAR();
    }
    if (IN(5)) { {
        REP(50) { const gg::Gemm g = gemm_Y(ws); gg::OrderS5 S{F.G, (int)blockIdx.x, (size_t)256 * 512 * 2}; Epi1<EpiY> E{EpiY{Gb}};
          gg::gemm_phase<Epi1<EpiY>, gg::OrderS5, true>(F.lds + RING_OFF, g, S, E); }
#if MK_FOURIER
        REP(51) { const gg::Gemm g = gemm_F3(ws); gg::OrderLin S{512, F.G, (int)blockIdx.x, (size_t)256 * 1024}; Epi1<EpiF3> E{EpiF3{CAT}};
          gg::gemm_phase<Epi1<EpiF3>, gg::OrderLin, true, true>(F.lds + RING_OFF, g, S, E); }
#endif
        }
        if (BOTH(5)) GRID_BAR();
    }
    if (IN(6)) { REP(6) {
        gg::Gemm g = gemm_GLU(ws);
        gg::Order2D S; S.init(MTOK / 256, 4096 / 256, F.G, (int)blockIdx.x, g.lda, g.ldb);
        EpiGluDrv E{EpiGLU{CAT, args.in[IN_GBA], args.in[IN_GBB]}};
        gg::gemm_phase<EpiGluDrv, gg::Order2D, true>(F.lds + RING_OFF, g, S, E);
        }
        if (BOTH(6)) GRID_BAR();
    }
    if (IN(7)) { REP(7) {
#if MK_FOURIER
        gg::Gemm g{(const char*)CAT, (const char*)Wout_t, DM * 2, DM * 2, DM / 64};
#else
        gg::Gemm g{(const char*)(CAT + FW), (const char*)(Wout_t + FW), DM * 2, DM * 2, FW / 64};
#endif
        gg::Order2D S; S.init(MTOK / 256, DM / 256, F.G, (int)blockIdx.x, g.lda, g.ldb);
        EpiResidB E{XR, mod + 2 * DM, 6 * DM};
        gg::gemm_phase<EpiResidB, gg::Order2D, true>(F.lds + RING_OFF, g, S, E);
        }
        if (BOTH(7)) GRID_BAR();
    }
    if (IN(8)) { REP(8) {
        { LAS float* P = (LAS float*)(F.lds + RING_OFF);
          __syncthreads();
          stage_mod_lds(F, P, args.in[IN_N2G], mod + 3 * DM, mod + 4 * DM, 0); stage_mod_lds(F, P, args.in[IN_N2G], mod + (size_t)6 * DM + 3 * DM, mod + (size_t)6 * DM + 4 * DM, 1);
          __syncthreads();
          for (int m = gw; m < MTOK; m += NGW) { const int b = m / SEQ; norm_mod_row_b_lds(XR + (size_t)m * DM, P + b * 2 * DM, P + b * 2 * DM + DM, Hn + (size_t)m * DM, F.lane); }
          __syncthreads(); }
        }
        if (BOTH(8)) GRID_BAR();
    }
    if (IN(9)) { REP(9) {
        gg::Gemm g{(const char*)Hn, (const char*)Wgu_t, DM * 2, DM * 2, DM / 64};
        gg::Order2D S; S.init(MTOK / 256, 2 * FFN / 256, F.G, (int)blockIdx.x, g.lda, g.ldb);
        EpiPairB<EpiSwiGLU> E{EpiSwiGLU{Hid}};
        gg::gemm_phase<EpiPairB<EpiSwiGLU>, gg::Order2D, true>(F.lds + RING_OFF, g, S, E);
        {
            const int rem = S.nwg % F.G, c = (int)blockIdx.x;
            if (rem == 0 || c >= rem) { int ib2 = 0; transpose_matrix<false>(F, args.in[IN_WD], FFN, DM, Wdn_t, 0, ib2, ((rem == 0 ? c : c - rem) * NWAVES + F.wave), (rem == 0 ? F.G : F.G - rem) * NWAVES); }
        }
        }
        if (BOTH(9)) GRID_BAR();
    }
    if (IN(10)) {
        gg::Gemm g{(const char*)Hid, (const char*)Wdn_t, FFN * 2, FFN * 2, FFN / 64};
        gg::Order2D S; S.init(MTOK / 256, DM / 256, F.G, (int)blockIdx.x, g.lda, g.ldb);
        EpiResidB E{XR, mod + 5 * DM, 6 * DM};
        gg::gemm_phase<EpiResidB, gg::Order2D, true>(F.lds + RING_OFF, g, S, E);
        if (BOTH(10)) GRID_BAR();
    }
    if (IN(11)) {
        const bool poison = (__hip_atomic_load(F.ctl + CW_TMO, RLX_AGENT) != 0u) || (__hip_atomic_load((gu32*)((unsigned*)(F.ctl + CW_BAR) + XB_TMO), RLX_AGENT) != 0u);
        LAS float* gl = (LAS float*)(F.lds + RING_OFF);
        __syncthreads();
        for (int i = F.tid * 4; i < DM; i += NWAVES * 64 * 4) *(LAS f32x4*)(gl + i) = *(const f32x4*)(args.in[IN_FG] + i);
        __syncthreads();
        for (int m = gw; m < MTOK; m += NGW) {
            norm_row_b2f_lds(XR + (size_t)m * DM, gl, out + (size_t)m * DM, F.lane);
            if (poison && F.lane == 0) out[(size_t)m * DM] = __builtin_nanf("");
        }
    }
#undef IN
#undef BOTH
}

extern "C" void kernel_launch(void* const* d_in, const int* in_sizes, int n_in, void* d_out, int out_size, void* d_ws, size_t ws_size, hipStream_t stream) {
    static int grid = 0;
    if (grid == 0) {
        if (n_in != 27 || out_size != MTOK * DM || ws_size < WS_END) { fprintf(stderr, "kernel_launch: unexpected shapes (n_in %d out %d ws %zu need %zu)\n", n_in, out_size, ws_size, (size_t)WS_END); grid = -1; return; }
        int dev = 0, cus = 0, per_cu = 0;
        if (hipGetDevice(&dev) != hipSuccess || hipDeviceGetAttribute(&cus, hipDeviceAttributeMultiprocessorCount, dev) != hipSuccess) { grid = -1; return; }
        if (hipFuncSetAttribute((const void*)mk_fwd, hipFuncAttributeMaxDynamicSharedMemorySize, LDS_BYTES) != hipSuccess) { fprintf(stderr, "kernel_launch: hipFuncSetAttribute failed\n"); grid = -1; return; }
        if (hipOccupancyMaxActiveBlocksPerMultiprocessor(&per_cu, (const void*)mk_fwd, NWAVES * 64, LDS_BYTES) != hipSuccess || per_cu < 1)
            fprintf(stderr, "kernel_launch: occupancy query reports %d\n", per_cu);
        (void)hipGetLastError();
        grid = cus;
    }
    if (grid < 0) return;
    (void)in_sizes;
    if (hipMemsetAsync((char*)d_ws + WS_CTL, 0, CTL_ZERO_BYTES, stream) != hipSuccess) return;
    Args a{};
    for (int i = 0; i < 27; ++i) a.in[i] = (const float*)d_in[i];
    a.out = (float*)d_out; a.ws = (unsigned char*)d_ws;
#if MK_PER_PHASE
    for (int p = 0; p < NPHASE; ++p) { a.ph_lo = p; a.ph_hi = p + 1; hipLaunchKernelGGL(mk_fwd, dim3(grid), dim3(NWAVES * 64), LDS_BYTES, stream, a); }
#else
    a.ph_lo = 0; a.ph_hi = NPHASE;
    hipLaunchKernelGGL(mk_fwd, dim3(grid), dim3(NWAVES * 64), LDS_BYTES, stream, a);
#endif
}
```
